# Optimizing an MI355X kernel written in HIP

```python
import jax, jax.numpy as jnp
from jax import lax
import numpy as np

D_MODEL = 2048
BATCH = 4
SEQ = 8192
DEPTH = 4

CHUNK = 64
N_EVEN = (DEPTH + 1) // 2
N_ODD = DEPTH // 2

POOL_WIDTH = D_MODEL // 2
POOL_WINDOWS = (2, 4, 8, 16)
POOL_GROUP = POOL_WIDTH // len(POOL_WINDOWS)
GLA_HEADS = 4
GLA_DV = (D_MODEL // 2) // GLA_HEADS
GLA_DK = GLA_DV // 2
GLA_GATE_RANK = 16
GLA_TAU = 16.0
OFF_Q = POOL_WIDTH
OFF_K = OFF_Q + GLA_HEADS * GLA_DK
OFF_V = OFF_K + GLA_HEADS * GLA_DK
OFF_R = OFF_V + GLA_HEADS * GLA_DV
OFF_LR = OFF_R + GLA_HEADS * GLA_DV
P_AB = OFF_LR + GLA_GATE_RANK
MIX_AB = POOL_WIDTH + GLA_HEADS * GLA_DV
ATT_HEADS = 16
ATT_HEAD_DIM = D_MODEL // ATT_HEADS
ATT_PAST_CHUNKS = 8
REL_CLIP = 256
FFN_DIM = 5504
CONV_WIDTH = 3
ALPHA = (2.0 * DEPTH) ** 0.25
BETA = (8.0 * DEPTH) ** -0.25
LN_EPS = 1e-5

kernel_name = "hybrid_pool_gla_chunkattn_deepnorm_adaln"


def layer_norm(x, g, b):
    xf = x.astype(jnp.float32)
    mu = jnp.mean(xf, axis=-1, keepdims=True)
    var = jnp.mean(jnp.square(xf - mu), axis=-1, keepdims=True)
    return ((xf - mu) * lax.rsqrt(var + LN_EPS)).astype(x.dtype) * g + b


def multiscale_pool(u, w_pool, pool_scale):
    S_ = u.shape[1]
    uf = u.astype(jnp.float32)
    cs = jnp.cumsum(uf, axis=1)
    t = jnp.arange(1, S_ + 1, dtype=jnp.float32)
    outs = []
    for gi, w in enumerate(POOL_WINDOWS):
        sl = slice(gi * POOL_GROUP, (gi + 1) * POOL_GROUP)
        cs_g = cs[:, :, sl]
        lagged = jnp.pad(cs_g[:, :S_ - w, :], ((0, 0), (w, 0), (0, 0)))
        count = jnp.minimum(t, float(w))[None, :, None]
        d = (cs_g - lagged) / count - uf[:, :, sl]
        outs.append(jnp.einsum('bsc,cd->bsd', d.astype(u.dtype), w_pool[gi]))
    return jnp.concatenate(outs, axis=-1) * pool_scale


def gla_chunked(q, k, v, log_a):
    B_, S_, H, DK = q.shape
    DV = v.shape[-1]
    nc = S_ // CHUNK

    def blocks(t):
        return t.astype(jnp.float32).reshape(B_, nc, CHUNK, H, t.shape[-1]).transpose(1, 0, 3, 2, 4)

    qb = blocks(q) * (DK ** -0.5)
    kb, vb, gb = blocks(k), blocks(v), blocks(log_a)
    b = jnp.cumsum(gb, axis=3)
    b_last = b[:, :, :, -1:, :]
    q_dec = qb * jnp.exp(b)
    k_inv = kb * jnp.exp(-b)
    k_dec = kb * jnp.exp(b_last - b)
    causal = jnp.tril(jnp.ones((CHUNK, CHUNK), dtype=bool))
    scores = jnp.where(causal, jnp.einsum('nbhid,nbhjd->nbhij', q_dec, k_inv), 0.0)
    o_intra = jnp.einsum('nbhij,nbhjv->nbhiv', scores, vb)
    decay = jnp.exp(b_last)

    def step(state, inp):
        q_n, k_n, v_n, decay_n = inp
        o_inter = jnp.einsum('bhid,bhdv->bhiv', q_n, state)
        state = decay_n[:, :, 0, :, None] * state + jnp.einsum('bhjd,bhjv->bhdv', k_n, v_n)
        return state, o_inter

    state0 = jnp.zeros((B_, H, DK, DV), jnp.float32)
    _, o_inter = lax.scan(step, state0, (q_dec, k_dec, vb, decay))
    o = o_intra + o_inter
    return o.transpose(1, 0, 3, 2, 4).reshape(B_, S_, H, DV)


def even_mixer(u, w_in, w_gate_lr, b_gate, gla_norm_g, w_pool, pool_scale, w_out):
    B_, S_, _ = u.shape
    z = u @ w_in
    q = z[..., OFF_Q:OFF_K].reshape(B_, S_, GLA_HEADS, GLA_DK)
    k = z[..., OFF_K:OFF_V].reshape(B_, S_, GLA_HEADS, GLA_DK)
    v = z[..., OFF_V:OFF_R].reshape(B_, S_, GLA_HEADS, GLA_DV)
    r = z[..., OFF_R:OFF_LR]
    gate_pre = z[..., OFF_LR:] @ w_gate_lr + b_gate
    log_a = (jax.nn.log_sigmoid(gate_pre.astype(jnp.float32)) / GLA_TAU).reshape(B_, S_, GLA_HEADS, GLA_DK)
    o = gla_chunked(q, k, v, log_a)
    mu = jnp.mean(o, axis=-1, keepdims=True)
    var = jnp.mean(jnp.square(o - mu), axis=-1, keepdims=True)
    o = ((o - mu) * lax.rsqrt(var + LN_EPS)).reshape(B_, S_, GLA_HEADS * GLA_DV).astype(u.dtype)
    y_b = jax.nn.silu(r) * (o * gla_norm_g)
    y_a = multiscale_pool(z[..., :POOL_WIDTH], w_pool, pool_scale)
    return jnp.concatenate([y_a, y_b], axis=-1) @ w_out


def chunk_band_attention(q, k, v, rel_bias):
    B_, S_, H, dh = q.shape
    nc = S_ // CHUNK
    pad = ATT_PAST_CHUNKS * CHUNK
    band = pad + CHUNK
    kp = jnp.pad(k, ((0, 0), (pad, 0), (0, 0), (0, 0)))
    vp = jnp.pad(v, ((0, 0), (pad, 0), (0, 0), (0, 0)))
    qi = jnp.arange(CHUNK)[:, None]
    kj = jnp.arange(band)[None, :]
    rel = jnp.clip(pad + qi - kj, -REL_CLIP, REL_CLIP) + REL_CLIP
    bias = rel_bias[:, rel].astype(jnp.float32)
    scale = dh ** -0.5

    def one_chunk(n):
        start = n * CHUNK
        q_n = lax.dynamic_slice_in_dim(q, start, CHUNK, axis=1)
        k_n = lax.dynamic_slice_in_dim(kp, start, band, axis=1)
        v_n = lax.dynamic_slice_in_dim(vp, start, band, axis=1)
        s = jnp.einsum('blhd,bjhd->bhlj', q_n, k_n).astype(jnp.float32) * scale + bias
        s = jnp.where(kj >= pad - start, s, -1e30)
        p = jax.nn.softmax(s, axis=-1).astype(v.dtype)
        return jnp.einsum('bhlj,bjhd->blhd', p, v_n)

    out = lax.map(one_chunk, jnp.arange(nc))
    return out.transpose(1, 0, 2, 3, 4).reshape(B_, S_, H * dh)


def odd_mixer(u, w_qkv, rel_bias, w_o):
    B_, S_, _ = u.shape
    qkv = (u @ w_qkv).reshape(B_, S_, 3, ATT_HEADS, ATT_HEAD_DIM)
    attn = chunk_band_attention(qkv[:, :, 0], qkv[:, :, 1], qkv[:, :, 2], rel_bias)
    return attn @ w_o


def conv_ffn(u, w_up, conv_w, conv_b, w_down):
    S_ = u.shape[1]
    h = u @ w_up
    a, g = h[..., :FFN_DIM], h[..., FFN_DIM:]
    gp = jnp.pad(g, ((0, 0), (CONV_WIDTH - 1, 0), (0, 0)))
    gc = conv_b
    for i in range(CONV_WIDTH):
        gc = gc + gp[:, i:i + S_, :] * conv_w[i]
    return (jax.nn.gelu(gc) * a) @ w_down


def setup_inputs(seed: int = 0) -> dict:
    key = jax.random.key(seed)
    ks = jax.random.split(key, 20)
    D = D_MODEL

    def nrm(k, shape, scale):
        return jax.random.normal(k, shape, jnp.float32) * scale

    return {
        "x": nrm(ks[0], (BATCH, SEQ, D), 1.0),
        "c": nrm(ks[1], (BATCH, D), 1.0),
        "w_ada": nrm(ks[2], (DEPTH, D, 6 * D), 0.2 * D ** -0.5),
        "b_ada": nrm(ks[3], (DEPTH, 6 * D), 0.01),
        "ln_g": 1.0 + nrm(ks[4], (DEPTH, 2, D), 0.02),
        "ln_b": nrm(ks[5], (DEPTH, 2, D), 0.02),
        "w_in_ab": nrm(ks[6], (N_EVEN, D, P_AB), D ** -0.5),
        "w_gate_lr": nrm(ks[7], (N_EVEN, GLA_GATE_RANK, GLA_HEADS * GLA_DK), GLA_GATE_RANK ** -0.5),
        "b_gate": nrm(ks[8], (N_EVEN, GLA_HEADS * GLA_DK), 0.1),
        "gla_norm_g": 1.0 + nrm(ks[9], (N_EVEN, GLA_HEADS * GLA_DV), 0.02),
        "w_pool": nrm(ks[10], (N_EVEN, len(POOL_WINDOWS), POOL_GROUP, POOL_GROUP), POOL_GROUP ** -0.5),
        "pool_scale": 1.0 + nrm(ks[11], (N_EVEN, POOL_WIDTH), 0.02),
        "w_out_ab": nrm(ks[12], (N_EVEN, MIX_AB, D), BETA * MIX_AB ** -0.5),
        "w_qkv": nrm(ks[13], (N_ODD, D, 3 * D), D ** -0.5),
        "rel_bias": nrm(ks[14], (N_ODD, ATT_HEADS, 2 * REL_CLIP + 1), 0.5),
        "w_o": nrm(ks[15], (N_ODD, D, D), BETA * D ** -0.5),
        "w_up": nrm(ks[16], (DEPTH, D, 2 * FFN_DIM), D ** -0.5),
        "conv_w": nrm(ks[17], (DEPTH, CONV_WIDTH, FFN_DIM), CONV_WIDTH ** -0.5),
        "conv_b": nrm(ks[18], (DEPTH, FFN_DIM), 0.02),
        "w_down": nrm(ks[19], (DEPTH, FFN_DIM, D), BETA * FFN_DIM ** -0.5),
    }


def reference(x, c, w_ada, b_ada, ln_g, ln_b, w_in_ab, w_gate_lr, b_gate, gla_norm_g, w_pool,
              pool_scale, w_out_ab, w_qkv, rel_bias, w_o, w_up, conv_w, conv_b, w_down):
    cond = jax.nn.silu(c)
    for l in range(DEPTH):
        mod = (cond @ w_ada[l] + b_ada[l])[:, None, :]
        sh1, sc1, g1, sh2, sc2, g2 = jnp.split(mod, 6, axis=-1)
        u = x * (1.0 + sc1) + sh1
        if l % 2 == 0:
            e = l // 2
            y = even_mixer(u, w_in_ab[e], w_gate_lr[e], b_gate[e], gla_norm_g[e],
                           w_pool[e], pool_scale[e], w_out_ab[e])
        else:
            o = l // 2
            y = odd_mixer(u, w_qkv[o], rel_bias[o], w_o[o])
        x = layer_norm(ALPHA * x + (1.0 + g1) * y, ln_g[l, 0], ln_b[l, 0])
        u = x * (1.0 + sc2) + sh2
        y = conv_ffn(u, w_up[l], conv_w[l], conv_b[l], w_down[l])
        x = layer_norm(ALPHA * x + (1.0 + g2) * y, ln_g[l, 1], ln_b[l, 1])
    return x
```

```cpp
#include <hip/hip_runtime.h>
#include <cstdio>
#include <cstdint>

#ifndef MK_ONE
#define MK_ONE 1
#endif
#ifndef MK_DEBUG
#define MK_DEBUG 0
#endif
#ifndef MK_MASK
#define MK_MASK 0xFFFFFFFFu
#endif
#define MKM(i) ((MK_MASK >> (i)) & 1u)

#define GAS __attribute__((address_space(1)))
#define LAS __attribute__((address_space(3)))
typedef unsigned short h16_t;
typedef _Float16 h16x8 __attribute__((ext_vector_type(8)));
typedef _Float16 h16x4 __attribute__((ext_vector_type(4)));
typedef _Float16 h16x2 __attribute__((ext_vector_type(2)));
typedef float f32x2 __attribute__((ext_vector_type(2)));
typedef float f32x4 __attribute__((ext_vector_type(4)));
typedef float f32x16 __attribute__((ext_vector_type(16)));
typedef unsigned u32x2 __attribute__((ext_vector_type(2)));
typedef unsigned u32x4 __attribute__((ext_vector_type(4)));
typedef short v4i16_t __attribute__((ext_vector_type(4)));

constexpr int NB = 4, SEQ = 8192, D = 2048, M = NB * SEQ, DEPTH = 4;
constexpr int FF = 5504, NUP = 2 * FF;
constexpr int PW = 1024, PGRP = 256;
constexpr int GH = 4, GDV = 256, GDK = 128, GRANK = 16;
constexpr int OFF_Q = 1024, OFF_K = 1536, OFF_V = 2048, OFF_R = 3072, OFF_LR = 4096, P_AB = 4112, P_PAD = 4352;
constexpr int AH = 16, ADH = 128, NQKV = 3 * D;
constexpr int CH = 64, NCHUNK = M / CH, CPS = SEQ / CH;
constexpr float ALPHA = 1.681792830507429f;
constexpr float LN_EPS = 1e-5f;
constexpr int MODW = 6 * D;
constexpr int KSPLIT = 16;

constexpr size_t MiB = 1u << 20;
constexpr size_t WS_CTL = 0, CTL_ZERO_BYTES = 1 * MiB;
constexpr size_t WS_MOD = 1 * MiB;
constexpr size_t WS_MODP = 2 * MiB;
constexpr size_t WS_WUP = 16 * MiB;
constexpr size_t WS_WDN = 188 * MiB;
constexpr size_t WS_WIN = 274 * MiB;
constexpr size_t WS_WOUT = 308 * MiB;
constexpr size_t WS_WQKV = 324 * MiB;
constexpr size_t WS_WO = 372 * MiB;
constexpr size_t WS_WPOOL = 388 * MiB;
constexpr size_t WS_U = 390 * MiB;
constexpr size_t WS_BIG = 518 * MiB;
constexpr size_t WS_Z = WS_BIG;
constexpr size_t WS_Y = WS_BIG + 384 * MiB;
constexpr size_t WS_QD = WS_BIG + 512 * MiB;
constexpr size_t WS_KD = WS_BIG + 544 * MiB;
constexpr size_t WS_OI = WS_U;
constexpr size_t WS_DEC = WS_BIG + 576 * MiB;
constexpr size_t WS_DP = WS_BIG + 577 * MiB;
constexpr size_t WS_H = WS_BIG;
constexpr size_t WS_RAWG = WS_BIG + 352 * MiB;
constexpr size_t WS_RAWA = WS_BIG + 400 * MiB;
constexpr size_t WS_DBG = WS_BIG + 642 * MiB;
constexpr size_t WS_END = WS_DBG + 256 * MiB;
constexpr size_t WS_NEED = MK_DEBUG ? WS_END : WS_DBG;

constexpr int CW_TMO = 0, CW_CODE = 1, CW_ERR = 2, CW_ERRV = 3;
constexpr int CW_BAR = 4096;

constexpr int RING_BYTES = 131072;
constexpr int LDSCTL_OFF = RING_BYTES, MISC_OFF = LDSCTL_OFF + 320;
constexpr int LDS_BYTES = 147456;
constexpr int NWAVES = 8, NTHR = 512;

#define LDS_WAIT() asm volatile("s_waitcnt lgkmcnt(0)" ::: "memory")
#define VM_WAIT() asm volatile("s_waitcnt vmcnt(0)" ::: "memory")

__device__ __forceinline__ int launder(int x) { asm volatile("" : "+v"(x)); return x; }
__device__ __forceinline__ unsigned pkh(float lo, float hi) { f32x2 v = {lo, hi}; h16x2 h = __builtin_convertvector(v, h16x2); return __builtin_bit_cast(unsigned, h); }
__device__ __forceinline__ float h2f(h16_t x) { return (float)__builtin_bit_cast(_Float16, x); }
__device__ __forceinline__ h16_t f2h(float x) { return __builtin_bit_cast(h16_t, (_Float16)x); }
__device__ __forceinline__ float wave_sum(float v) {
#pragma unroll
    for (int o = 1; o < 64; o <<= 1) v += __shfl_xor(v, o);
    return v;
}
__device__ __forceinline__ float sigmoidf_(float x) { return 1.0f / (1.0f + __expf(-x)); }
__device__ __forceinline__ float gelu_tanh(float x) {
    const float u = 0.7978845608028654f * (x + 0.044715f * x * x * x);
    const float t = __builtin_amdgcn_exp2f(-2.0f * 1.4426950408889634f * u);
    return x * __builtin_amdgcn_rcpf(1.0f + t);
}
__device__ __forceinline__ float log_sigmoid(float x) { return fminf(x, 0.f) - log1pf(__expf(-fabsf(x))); }

namespace pg8 {
constexpr int BM = 256, BK = 64, HALF = 128, HTB = HALF * BK * 2, STAGE_BYTES = 8 * HTB, NXCD = 8, WGM = 8;
__host__ __device__ __forceinline__ int lds_byte(int r, int c) { const int st = (r >> 4) * 2 + (c >> 5), rr = r & 15, cc = c & 31, ob = rr * 64 + cc * 2; return st * 1024 + (ob ^ (((ob >> 9) & 1) << 5)); }
__host__ __device__ __forceinline__ void stage_rc(int b, int& R, int& C) { const int st = b / 1024, sb = b % 1024, swz = sb ^ (((sb >> 9) & 1) << 5); R = (st >> 1) * 16 + swz / 64; C = (st & 1) * 32 + (swz % 64) / 2; }
__host__ __device__ __forceinline__ int perm32(int rho) { const int n = rho >> 4, i = rho & 15; return 8 * (i >> 2) + 4 * n + (i & 3); }

struct Unit { int pm, pn; };
struct Gemm { const h16_t* A; const h16_t* Bt; int lda, ldb, K, akoff; };

struct StaticOrder {
    int nM, nN, nwg, G, c;
    __host__ __device__ void init(int M_, int N_, int G_, int c_) { nM = M_ / BM; nN = N_ / BM; nwg = nM * nN; G = G_; c = c_; }
    __host__ __device__ bool next(int i, Unit& u) const {
        const long L = (long)i * G + c; if (L >= nwg || c < 0) return false;
        int wgid = (int)L; { const int q = nwg / NXCD, r = nwg % NXCD, xcd = wgid % NXCD, off = wgid / NXCD; wgid = (xcd < r ? xcd * (q + 1) : r * (q + 1) + (xcd - r) * q) + off; }
        const int nig = WGM * nN, gid = wgid / nig, fm = gid * WGM, gsz = (nM - fm) < WGM ? (nM - fm) : WGM;
        u.pm = fm + ((wgid % nig) % gsz); u.pn = (wgid % nig) / gsz; return true;
    }
};

struct EpiStoreH {
    static constexpr bool PERM = true;
    h16_t* O; int ldc; const float* colscale;
    __device__ __forceinline__ void operator()(const f32x4 (&acc)[2][2][4][2], const Unit& u, int wr, int wc, int fr_, int fq_) const {
        int fr = fr_, fq = fq_; asm volatile("" : "+v"(fr), "+v"(fq));
        const int row0 = u.pm * BM + wr * 64 + fr; const int col0 = u.pn * BM + wc * 32 + 8 * fq;
        f32x4 cs[2][2];
#pragma unroll
        for (int bj = 0; bj < 2; ++bj)
#pragma unroll
            for (int n = 0; n < 2; ++n) cs[bj][n] = colscale ? *(const f32x4*)(colscale + col0 + bj * HALF + 4 * n) : (f32x4){1.f, 1.f, 1.f, 1.f};
#pragma unroll
        for (int ai = 0; ai < 2; ++ai)
#pragma unroll
            for (int m = 0; m < 4; ++m) { h16_t* rowp = O + (size_t)(row0 + ai * HALF + m * 16) * ldc + col0;
#pragma unroll
                for (int bj = 0; bj < 2; ++bj) { const f32x4 v0 = acc[ai][bj][m][0] * cs[bj][0], v1 = acc[ai][bj][m][1] * cs[bj][1];
                    u32x4 w; w.x = pkh(v0[0], v0[1]); w.y = pkh(v0[2], v0[3]); w.z = pkh(v1[0], v1[1]); w.w = pkh(v1[2], v1[3]);
                    *(u32x4*)(rowp + bj * HALF) = w; } }
    }
};
struct EpiResid {
    static constexpr bool PERM = false;
    const float* xin; float* xout; const float* gate;
    __device__ __forceinline__ void operator()(const f32x4 (&acc)[2][2][4][2], const Unit& u, int wr, int wc, int fr_, int fq_) const {
        int fr = fr_, fq = fq_; asm volatile("" : "+v"(fr), "+v"(fq));
        const int col0 = u.pn * BM + wc * 32 + 4 * fq; const int b = u.pm >> 5;
        f32x4 gv[2][2];
#pragma unroll
        for (int bj = 0; bj < 2; ++bj)
#pragma unroll
            for (int n = 0; n < 2; ++n) gv[bj][n] = *(const f32x4*)(gate + (size_t)b * MODW + col0 + bj * HALF + n * 16) + 1.0f;
#pragma unroll
        for (int ai = 0; ai < 2; ++ai)
#pragma unroll
            for (int m = 0; m < 4; ++m) { const size_t off = (size_t)(u.pm * BM + ai * HALF + wr * 64 + m * 16 + fr) * D + col0;
#pragma unroll
                for (int bj = 0; bj < 2; ++bj)
#pragma unroll
                    for (int n = 0; n < 2; ++n) { const f32x4 xv = *(const f32x4*)(xin + off + bj * HALF + n * 16);
                        *(f32x4*)(xout + off + bj * HALF + n * 16) = xv * ALPHA + gv[bj][n] * acc[ai][bj][m][n]; }
                if (m & 1) asm volatile("" ::: "memory"); }
    }
};
__device__ __forceinline__ float dpp_prev1(float cur, float prv) {
    const int o = __builtin_amdgcn_update_dpp(0, __builtin_bit_cast(int, prv), 0x121  , 0xf, 0xf, false);
    return __builtin_bit_cast(float, __builtin_amdgcn_update_dpp(o, __builtin_bit_cast(int, cur), 0x111  , 0xf, 0xf, false));
}
__device__ __forceinline__ float dpp_prev2(float cur, float prv) {
    const int o = __builtin_amdgcn_update_dpp(0, __builtin_bit_cast(int, prv), 0x122  , 0xf, 0xf, false);
    return __builtin_bit_cast(float, __builtin_amdgcn_update_dpp(o, __builtin_bit_cast(int, cur), 0x112  , 0xf, 0xf, false));
}
struct EpiFFN {
    static constexpr bool PERM = true;
    h16_t* Hout; const float* cw; const float* cb; float* rawg; float* rawa;
    __device__ __forceinline__ void operator()(const f32x4 (&acc)[2][2][4][2], const Unit& u, int wr, int wc, int fr_, int fq_) const {
        int fr = fr_, fq = fq_; asm volatile("" : "+v"(fr), "+v"(fq));
#pragma unroll
        for (int n = 0; n < 2; ++n) {
            const unsigned j = (unsigned)(u.pn * HALF + wc * 32 + 8 * fq + 4 * n);
            const f32x4 w0 = *(const f32x4*)(cw + j), w1 = *(const f32x4*)(cw + FF + j), w2 = *(const f32x4*)(cw + 2 * FF + j), bb = *(const f32x4*)(cb + j);
#pragma unroll
            for (int ai = 0; ai < 2; ++ai) {
                const int blk = u.pm * 4 + ai * 2 + wr;
#pragma unroll
                for (int m = 0; m < 4; ++m) {
                    const f32x4 g = acc[ai][1][m][n], a = acc[ai][0][m][n], gp = acc[ai][1][m == 0 ? 0 : m - 1][n];
                    f32x4 r;
#pragma unroll
                    for (int e = 0; e < 4; ++e) { const float g1 = dpp_prev1(g[e], gp[e]), g2 = dpp_prev2(g[e], gp[e]);
                        r[e] = gelu_tanh(bb[e] + w0[e] * g2 + w1[e] * g1 + w2[e] * g[e]) * a[e]; }
                    u32x2 hw; hw.x = pkh(r[0], r[1]); hw.y = pkh(r[2], r[3]);
                    if (m == 0) { if (fr < 2) { const unsigned o = (unsigned)((blk * 4 + fr) * FF) + j, o2 = (unsigned)((blk * 2 + fr) * FF) + j; *(f32x4*)(rawg + o) = g; *(f32x4*)(rawa + o2) = a; }
                                  else *(u32x2*)(Hout + (unsigned)((blk * 64 + fr) * FF) + j) = hw; }
                    else { *(u32x2*)(Hout + (unsigned)((blk * 64 + m * 16 + fr) * FF) + j) = hw;
                           if (m == 3 && fr >= 14) { const unsigned o = (unsigned)((blk * 4 + fr - 12) * FF) + j; *(f32x4*)(rawg + o) = g; } }
                }
            }
            asm volatile("" ::: "memory");
        }
    }
};

template <class Epi, class Sched>
__device__ __forceinline__ void gemm_phase(LAS unsigned char* lds, const Gemm g, const Sched& S, const Epi& E) {
    const int tid = launder((int)threadIdx.x), wid = __builtin_amdgcn_readfirstlane(tid >> 6), lane = tid & 63, wr = wid >> 2, wc = wid & 3, fr = lane & 15, fq = lane >> 4;
    const int K = g.K, nt = K / BK;
    unsigned voffA[2], voffB[2];
#pragma unroll
    for (int i = 0; i < 2; ++i) { int R, C; stage_rc(tid * 16 + i * 8192, R, C); const int Rb = Epi::PERM ? ((R & ~31) + perm32(R & 31)) : R;
        voffA[i] = (unsigned)(R * g.lda + C) * 2u; voffB[i] = (unsigned)(Rb * g.ldb + C) * 2u; }
    const size_t kstep = (size_t)(BK * 2);
    const size_t hstepA = (size_t)HALF * g.lda * 2, hstepB = (size_t)HALF * g.ldb * 2;
    const size_t tstepA = 2 * hstepA, tstepB = 2 * hstepB;
    const unsigned ldsw = (unsigned)wid * 1024u;
    const int aoff = lds_byte(wr * 64 + fr, fq * 8), boff = lds_byte(wc * 32 + fr, fq * 8);
#define PG8_SA(b, h) (((b) * 2 + (h)) * HTB)
#define PG8_SB(b, h) ((4 + (b) * 2 + (h)) * HTB)
#define PG8_STAGE(bufoff, gbase, voff) do { _Pragma("unroll") for (int _i = 0; _i < 2; ++_i) \
        __builtin_amdgcn_global_load_lds((const unsigned*)((const char*)(gbase) + (voff)[_i]), (LAS unsigned*)(lds + (bufoff) + ldsw + _i * 8192), 16, 0, 0); } while (0)
#define PG8_LDA(dst, b, h) do { _Pragma("unroll") for (int m = 0; m < 4; ++m) _Pragma("unroll") for (int k = 0; k < 2; ++k) dst[m][k] = *(const LAS h16x8*)(lds + PG8_SA(b, h) + aoff + m * 2048 + k * 1024); } while (0)
#define PG8_LDB(dst, b, h) do { _Pragma("unroll") for (int n = 0; n < 2; ++n) _Pragma("unroll") for (int k = 0; k < 2; ++k) dst[n][k] = *(const LAS h16x8*)(lds + PG8_SB(b, h) + boff + n * 2048 + k * 1024); } while (0)
#define PG8_MMA(ai, bj, At, Bt) do { __builtin_amdgcn_s_setprio(1); _Pragma("unroll") for (int m = 0; m < 4; ++m) _Pragma("unroll") for (int n = 0; n < 2; ++n) _Pragma("unroll") for (int k = 0; k < 2; ++k) \
        acc[ai][bj][m][n] = __builtin_amdgcn_mfma_f32_16x16x32_f16(Bt[n][k], At[m][k], acc[ai][bj][m][n], 0, 0, 0); __builtin_amdgcn_s_setprio(0); } while (0)
#define PG8_WAIT_V(n) asm volatile("s_waitcnt vmcnt(" #n ")" ::: "memory")
#define PG8_WAIT_L(n) asm volatile("s_waitcnt lgkmcnt(" #n ")" ::: "memory")
#define PG8_BAR __builtin_amdgcn_s_barrier()
#define PG8_SCHED __builtin_amdgcn_sched_barrier(0)
    Unit cur, nxt; int ui = 0;
    if (!S.next(0, cur)) return;
    f32x4 acc[2][2][4][2];
#pragma unroll
    for (int a = 0; a < 2; ++a)
#pragma unroll
        for (int b = 0; b < 2; ++b)
#pragma unroll
            for (int m = 0; m < 4; ++m)
#pragma unroll
                for (int n = 0; n < 2; ++n) acc[a][b][m][n] = (f32x4){0.f, 0.f, 0.f, 0.f};
    h16x8 At[4][2], B0[2][2], B1[2][2];
    const char* cA = (const char*)g.A + (size_t)cur.pm * tstepA + (size_t)cur.pn * g.akoff * 2; const char* cB = (const char*)g.Bt + (size_t)cur.pn * tstepB;
    PG8_STAGE(PG8_SB(0, 0), cB, voffB); PG8_STAGE(PG8_SB(0, 1), cB + hstepB, voffB); PG8_STAGE(PG8_SA(0, 0), cA, voffA); PG8_STAGE(PG8_SA(0, 1), cA + hstepA, voffA);
    if (wr == 1) PG8_BAR;
    PG8_WAIT_V(2); PG8_BAR;
    PG8_STAGE(PG8_SB(1, 0), cB + kstep, voffB); PG8_STAGE(PG8_SA(1, 0), cA + kstep, voffA); PG8_STAGE(PG8_SB(1, 1), cB + hstepB + kstep, voffB);
    PG8_WAIT_V(6); PG8_BAR;
    for (;;) {
        const bool has_next = S.next(ui + 1, nxt);
        const char* nA = has_next ? (const char*)g.A + (size_t)nxt.pm * tstepA + (size_t)nxt.pn * g.akoff * 2 : cA; const char* nB = has_next ? (const char*)g.Bt + (size_t)nxt.pn * tstepB : cB;
        for (int t = 0; t < nt; t += 2) {
            const bool last = (t == nt - 2);
            const char* a1 = cA + (size_t)(t + 1) * kstep;
            const char* a2 = last ? nA : cA + (size_t)(t + 2) * kstep; const char* b2 = last ? nB : cB + (size_t)(t + 2) * kstep;
            const char* a3 = a2 + kstep; const char* b3 = b2 + kstep;
            PG8_LDB(B0, 0, 0); PG8_LDB(B1, 0, 1); PG8_SCHED; PG8_LDA(At, 0, 0); PG8_STAGE(PG8_SA(1, 1), a1 + hstepA, voffA);
            PG8_WAIT_V(8); PG8_WAIT_L(0); PG8_BAR; PG8_MMA(0, 0, At, B0); PG8_MMA(0, 1, At, B1); PG8_BAR; PG8_SCHED;
            PG8_LDA(At, 0, 1); PG8_STAGE(PG8_SB(0, 0), b2, voffB); PG8_STAGE(PG8_SB(0, 1), b2 + hstepB, voffB); PG8_STAGE(PG8_SA(0, 0), a2, voffA);
            PG8_WAIT_V(8); PG8_WAIT_L(0); PG8_BAR; PG8_MMA(1, 0, At, B0); PG8_MMA(1, 1, At, B1); PG8_BAR; PG8_SCHED;
            PG8_LDB(B0, 1, 0); PG8_LDB(B1, 1, 1); PG8_SCHED; PG8_LDA(At, 1, 0); PG8_STAGE(PG8_SA(0, 1), a2 + hstepA, voffA);
            PG8_WAIT_V(8); PG8_WAIT_L(0); PG8_BAR; PG8_MMA(0, 0, At, B0); PG8_MMA(0, 1, At, B1); PG8_BAR; PG8_SCHED;
            PG8_LDA(At, 1, 1); PG8_STAGE(PG8_SB(1, 0), b3, voffB); PG8_STAGE(PG8_SB(1, 1), b3 + hstepB, voffB); PG8_STAGE(PG8_SA(1, 0), a3, voffA);
            PG8_WAIT_V(8); PG8_WAIT_L(0); PG8_BAR; PG8_MMA(1, 0, At, B0); PG8_MMA(1, 1, At, B1); PG8_BAR; PG8_SCHED;
        }
        if (wr == 0) PG8_BAR;
        E(acc, cur, wr, wc, fr, fq);
        if (!has_next) break;
#pragma unroll
        for (int a = 0; a < 2; ++a)
#pragma unroll
            for (int b = 0; b < 2; ++b)
#pragma unroll
                for (int m = 0; m < 4; ++m)
#pragma unroll
                    for (int n = 0; n < 2; ++n) acc[a][b][m][n] = (f32x4){0.f, 0.f, 0.f, 0.f};
        cur = nxt; cA = nA; cB = nB; ++ui;
        if (wr == 1) PG8_BAR;
    }
    PG8_WAIT_V(0);
    PG8_BAR;
#undef PG8_SA
#undef PG8_SB
#undef PG8_STAGE
#undef PG8_LDA
#undef PG8_LDB
#undef PG8_MMA
#undef PG8_WAIT_V
#undef PG8_WAIT_L
#undef PG8_BAR
#undef PG8_SCHED
}
}

#define XB_TMO      128
#define XB_XCNT(j)  (256  + 64 * (j))
#define XB_XSUB(j)  (1280 + 64 * (j))
#define XB_XGEN(j)  (2304 + 64 * (j))
#define XB_TOP      3328
#define XB_TOPGEN   3392
#define XCD_BAR_WORDS 3456
#define XB_SPIN_CAP (1u << 18)
__device__ __forceinline__ unsigned xb_ld(unsigned* p)              { return __hip_atomic_load(p, __ATOMIC_RELAXED, __HIP_MEMORY_SCOPE_AGENT); }
__device__ __forceinline__ unsigned xb_add(unsigned* p, unsigned v) { return __hip_atomic_fetch_add(p, v, __ATOMIC_RELAXED, __HIP_MEMORY_SCOPE_AGENT); }
__device__ __forceinline__ unsigned xb_xcc_id() { return (unsigned)__builtin_amdgcn_s_getreg((3 << 11) | 20) & 0xFu; }
#define XB_SPIN(cond, bar) do { unsigned _sp = 0; while (cond) { __builtin_amdgcn_s_sleep(1); \
    if ((++_sp & 255u) == 0u) { if (xb_ld(&(bar)[XB_TMO])) break; if (_sp > XB_SPIN_CAP) { atomicAdd(&(bar)[XB_TMO], 1u); break; } } } } while (0)
struct XcdBarrier { unsigned* bar; unsigned x; volatile LAS unsigned* st; };
__device__ __forceinline__ XcdBarrier xcd_barrier_post(unsigned* bar, volatile LAS unsigned* st) {
    XcdBarrier b; b.bar = bar; b.x = xb_xcc_id(); b.st = st;
    if (threadIdx.x == 0) (void)xb_add(&bar[XB_XCNT(b.x)], 1u);
    return b;
}
__device__ __forceinline__ void xcd_barrier_complete(unsigned* bar, unsigned x, unsigned& nloc, unsigned& nx) {
    const unsigned G = gridDim.x * gridDim.y * gridDim.z;
    unsigned sum, cnt, mine, sp = 0u;
    for (;;) {
        sum = 0u; cnt = 0u; mine = 0u;
#pragma unroll
        for (unsigned j = 0; j < 16; ++j) { const unsigned c = xb_ld(&bar[XB_XCNT(j)]); sum += c; cnt += (c > 0u) ? 1u : 0u; mine = (j == x) ? c : mine; }
        if (sum == G) break;
        __builtin_amdgcn_s_sleep(1);
        if ((++sp & 255u) == 0u) { if (xb_ld(&bar[XB_TMO])) break; if (sp > XB_SPIN_CAP) { atomicAdd(&bar[XB_TMO], 1u); break; } }
    }
    nloc = mine > 0u ? mine : 1u; nx = cnt > 0u ? cnt : 1u;
}
__device__ __forceinline__ void xcd_barrier(const XcdBarrier& b) {
    asm volatile("s_waitcnt vmcnt(0)" ::: "memory");
    __syncthreads();
    if (threadIdx.x == 0) {
        unsigned* bar = b.bar;
        __builtin_amdgcn_s_waitcnt(0);
        unsigned nloc = b.st[0], nx = b.st[1];
        if (nloc == 0u) { xcd_barrier_complete(bar, b.x, nloc, nx); b.st[0] = nloc; b.st[1] = nx; }
        const unsigned old = xb_add(&bar[XB_XSUB(b.x)], 1u);
        const unsigned gen = old / nloc;
        if (old + 1u == (gen + 1u) * nloc) {
            __builtin_amdgcn_fence(__ATOMIC_RELEASE, "agent");
            asm volatile("s_waitcnt vmcnt(0)" ::: "memory");
            const unsigned og = xb_add(&bar[XB_TOP], 1u);
            const unsigned tg = og / nx;
            if (og + 1u == (tg + 1u) * nx) xb_add(&bar[XB_TOPGEN], 1u);
            else XB_SPIN(xb_ld(&bar[XB_TOPGEN]) == tg, bar);
            __builtin_amdgcn_fence(__ATOMIC_ACQUIRE, "agent");
            xb_add(&bar[XB_XGEN(b.x)], 1u);
            asm volatile("s_waitcnt vmcnt(0)" ::: "memory");
        } else {
            XB_SPIN(xb_ld(&bar[XB_XGEN(b.x)]) == gen, bar);
            __builtin_amdgcn_fence(__ATOMIC_ACQUIRE, "agent");
            asm volatile("s_waitcnt vmcnt(0)" ::: "memory");
        }
    }
    __syncthreads();
}

struct Ctx {
    LAS unsigned char* lds;
    int tid, lane, wave, G, bid;
    const float* in[20]; float* out; unsigned char* ws;
};
enum { I_X = 0, I_C, I_WADA, I_BADA, I_LNG, I_LNB, I_WIN, I_WGLR, I_BGATE, I_GNG, I_WPOOL, I_PSCALE, I_WOUT, I_WQKV, I_RELB, I_WO, I_WUP, I_CONVW, I_CONVB, I_WDOWN };

__device__ __forceinline__ v4i16_t tr_read(const LAS unsigned char* p) { return __builtin_amdgcn_ds_read_tr16_b64_v4i16((LAS v4i16_t*)p); }
__device__ __forceinline__ h16x8 tr_pair(const LAS unsigned char* p, int second_off) {
    const v4i16_t a = tr_read(p), b = tr_read(p + second_off);
    typedef short s16x8 __attribute__((ext_vector_type(8)));
    const s16x8 r = {a[0], a[1], a[2], a[3], b[0], b[1], b[2], b[3]};
    return __builtin_bit_cast(h16x8, r);
}
__device__ __forceinline__ h16x8 pack8(float a0, float a1, float a2, float a3, float a4, float a5, float a6, float a7) {
    u32x4 w; w.x = pkh(a0, a1); w.y = pkh(a2, a3); w.z = pkh(a4, a5); w.w = pkh(a6, a7); return __builtin_bit_cast(h16x8, w);
}

__device__ __forceinline__ unsigned upmap(int n) { const int j = n < FF ? n : n - FF; return (unsigned)(256 * (j >> 7) + (j & 127) + (n < FF ? 0 : 128)); }
template <bool UPMAP>
__device__ __forceinline__ void tr_item(const float* W, int K, int ldw, int nvalid, h16_t* WT, LAS float* scr, int kb, int nb, int lane) {
    const int k0 = 64 * kb, n0 = 32 * nb;
    const int nn = n0 + (lane & 31); const bool ok = nn < nvalid;
#pragma unroll 8
    for (int i = 0; i < 32; ++i) { const int kk = 2 * i + (lane >> 5); scr[kk * 33 + (lane & 31)] = ok ? W[(size_t)(k0 + kk) * ldw + nn] : 0.f; }
    LDS_WAIT(); asm volatile("" ::: "memory");
    const int c = lane & 7;
#pragma unroll
    for (int j = 0; j < 4; ++j) { const int nl = (lane >> 3) + 8 * j; const int n = n0 + nl; const LAS float* s = scr + (8 * c) * 33 + nl;
        u32x4 o; o.x = pkh(s[0 * 33], s[1 * 33]); o.y = pkh(s[2 * 33], s[3 * 33]); o.z = pkh(s[4 * 33], s[5 * 33]); o.w = pkh(s[6 * 33], s[7 * 33]);
        const unsigned drow = UPMAP ? upmap(n) : (unsigned)n;
        *(u32x4*)(WT + (size_t)drow * K + k0 + 8 * c) = o; }
    LDS_WAIT(); asm volatile("" ::: "memory");
}
constexpr int IT_MOD = DEPTH * 48 * KSPLIT;
constexpr int IT_UP = 32 * 344, IT_DN = 86 * 64, IT_LAYER = IT_UP + IT_DN;
constexpr int IT_IN = 32 * 136, IT_OUT = 32 * 64, IT_POOL = 4 * 4 * 8, IT_EVEN = IT_IN + IT_OUT + IT_POOL;
constexpr int IT_QKV = 32 * 192, IT_O = 32 * 64, IT_ODD = IT_QKV + IT_O;
constexpr int IT_TOTAL = IT_MOD + 4 * IT_LAYER + 2 * IT_EVEN + 2 * IT_ODD;

__device__ __forceinline__ void step_prologue(Ctx& F) {
    LAS float* scr = (LAS float*)(F.lds + F.wave * 16384);
    const int gw = F.bid * NWAVES + F.wave, NGW = F.G * NWAVES, lane = launder(F.lane);
    for (int it = gw; it < IT_TOTAL; it += NGW) {
        int r = it;
        if (r < IT_MOD) {
            const int l = r / (48 * KSPLIT), rem = r % (48 * KSPLIT), ng = rem / KSPLIT, ks = rem % KSPLIT;
#pragma unroll
            for (int i = 0; i < 8; ++i) { const int idx = lane + 64 * i, b = idx >> 7, kk = idx & 127; const float c = F.in[I_C][b * D + ks * 128 + kk]; scr[idx] = c * sigmoidf_(c); }
            LDS_WAIT(); asm volatile("" ::: "memory");
            const int n0 = ng * 256 + lane * 4;
            const float* wp = F.in[I_WADA] + ((size_t)l * D + ks * 128) * MODW + n0;
            f32x4 a0 = {0.f, 0.f, 0.f, 0.f}, a1 = a0, a2 = a0, a3 = a0;
#pragma unroll 8
            for (int kk = 0; kk < 128; ++kk) { const f32x4 w = *(const f32x4*)(wp + (size_t)kk * MODW);
                a0 += w * scr[kk]; a1 += w * scr[128 + kk]; a2 += w * scr[256 + kk]; a3 += w * scr[384 + kk]; }
            float* mp = (float*)(F.ws + WS_MODP) + ((size_t)(ks * DEPTH + l) * NB) * MODW + n0;
            *(f32x4*)(mp) = a0; *(f32x4*)(mp + MODW) = a1; *(f32x4*)(mp + 2 * MODW) = a2; *(f32x4*)(mp + 3 * MODW) = a3;
            LDS_WAIT(); asm volatile("" ::: "memory");
            continue;
        }
        r -= IT_MOD;
        if (r < 4 * IT_LAYER) {
            const int l = r / IT_LAYER; r %= IT_LAYER;
            if (r < IT_UP) { tr_item<true>(F.in[I_WUP] + (size_t)l * D * NUP, D, NUP, NUP, (h16_t*)(F.ws + WS_WUP) + (size_t)l * NUP * D, scr, r / 344, r % 344, lane); continue; }
            r -= IT_UP;
            tr_item<false>(F.in[I_WDOWN] + (size_t)l * FF * D, FF, D, D, (h16_t*)(F.ws + WS_WDN) + (size_t)l * D * FF, scr, r / 64, r % 64, lane); continue;
        }
        r -= 4 * IT_LAYER;
        if (r < 2 * IT_EVEN) {
            const int e = r / IT_EVEN; r %= IT_EVEN;
            if (r < IT_IN) { tr_item<false>(F.in[I_WIN] + (size_t)e * D * P_AB, D, P_AB, P_AB, (h16_t*)(F.ws + WS_WIN) + (size_t)e * P_PAD * D, scr, r / 136, r % 136, lane); continue; }
            r -= IT_IN;
            if (r < IT_OUT) { tr_item<false>(F.in[I_WOUT] + (size_t)e * D * D, D, D, D, (h16_t*)(F.ws + WS_WOUT) + (size_t)e * D * D, scr, r / 64, r % 64, lane); continue; }
            r -= IT_OUT;
            const int gi = r / 32; r %= 32;
            tr_item<false>(F.in[I_WPOOL] + ((size_t)e * 4 + gi) * PGRP * PGRP, PGRP, PGRP, PGRP, (h16_t*)(F.ws + WS_WPOOL) + ((size_t)e * 4 + gi) * PGRP * PGRP, scr, r / 8, r % 8, lane); continue;
        }
        r -= 2 * IT_EVEN;
        {
            const int o = r / IT_ODD; r %= IT_ODD;
            if (r < IT_QKV) { tr_item<false>(F.in[I_WQKV] + (size_t)o * D * NQKV, D, NQKV, NQKV, (h16_t*)(F.ws + WS_WQKV) + (size_t)o * NQKV * D, scr, r / 192, r % 192, lane); continue; }
            r -= IT_QKV;
            tr_item<false>(F.in[I_WO] + (size_t)o * D * D, D, D, D, (h16_t*)(F.ws + WS_WO) + (size_t)o * D * D, scr, r / 64, r % 64, lane);
        }
    }
}

__device__ __forceinline__ void step_mod_u0(Ctx& F) {
    const float* modp = (const float*)(F.ws + WS_MODP); float* mod = (float*)(F.ws + WS_MOD);
    for (int i = F.bid * NTHR + launder(F.tid); i < DEPTH * NB * MODW / 4; i += F.G * NTHR) {
        const int lb = i / (MODW / 4), n = (i % (MODW / 4)) * 4, l = lb / NB;
        f32x4 s = *(const f32x4*)(F.in[I_BADA] + (size_t)l * MODW + n);
#pragma unroll
        for (int ks = 0; ks < KSPLIT; ++ks) s += *(const f32x4*)(modp + ((size_t)ks * DEPTH * NB + lb) * MODW + n);
        *(f32x4*)(mod + (size_t)lb * MODW + n) = s;
    }
    const int gw = F.bid * NWAVES + F.wave, NGW = F.G * NWAVES, lane = launder(F.lane);
    h16_t* U = (h16_t*)(F.ws + WS_U);
    for (int blk = gw; blk < M / 16; blk += NGW) {
        const int b = blk >> 9;
        f32x4 sc[8], sh[8];
#pragma unroll
        for (int j = 0; j < 8; ++j) { const int col = 4 * lane + 256 * j;
            f32x4 a = *(const f32x4*)(F.in[I_BADA] + col), c = *(const f32x4*)(F.in[I_BADA] + D + col);
            for (int ks = 0; ks < KSPLIT; ++ks) { const float* p = modp + ((size_t)ks * DEPTH * NB + b) * MODW; a += *(const f32x4*)(p + col); c += *(const f32x4*)(p + D + col); }
            sh[j] = a; sc[j] = c + 1.0f; }
        for (int r = 0; r < 16; ++r) { const size_t row = (size_t)blk * 16 + r;
#pragma unroll
            for (int j = 0; j < 8; ++j) { const int col = 4 * lane + 256 * j; const f32x4 x = *(const f32x4*)(F.in[I_X] + row * D + col); const f32x4 u = x * sc[j] + sh[j];
                u32x2 w; w.x = pkh(u[0], u[1]); w.y = pkh(u[2], u[3]); *(u32x2*)(U + row * D + col) = w; } }
    }
}

__device__ __forceinline__ void step_ln(Ctx& F, int l, int which) {
    const int gw = F.bid * NWAVES + F.wave, NGW = F.G * NWAVES, lane = launder(F.lane);
    float* X = F.out; h16_t* U = (h16_t*)(F.ws + WS_U); const float* mod = (const float*)(F.ws + WS_MOD);
    const bool has_u = !(l == DEPTH - 1 && which == 1);
    const int lu = which == 0 ? l : (l + 1 < DEPTH ? l + 1 : l); const int off_sh = which == 0 ? 3 * D : 0, off_sc = which == 0 ? 4 * D : D;
    const float* gp = F.in[I_LNG] + (size_t)(l * 2 + which) * D; const float* bp = F.in[I_LNB] + (size_t)(l * 2 + which) * D;
    for (int blk = gw; blk < M / 16; blk += NGW) {
        const int b = blk >> 9;
        f32x4 g[8], bb[8], sc[8], sh[8];
#pragma unroll
        for (int j = 0; j < 8; ++j) { const int col = 4 * lane + 256 * j; g[j] = *(const f32x4*)(gp + col); bb[j] = *(const f32x4*)(bp + col);
            sc[j] = *(const f32x4*)(mod + ((size_t)lu * NB + b) * MODW + off_sc + col) + 1.0f; sh[j] = *(const f32x4*)(mod + ((size_t)lu * NB + b) * MODW + off_sh + col); }
        for (int r = 0; r < 16; ++r) { const size_t row = (size_t)blk * 16 + r;
            f32x4 v[8]; float s = 0.f;
#pragma unroll
            for (int j = 0; j < 8; ++j) { v[j] = *(const f32x4*)(X + row * D + 4 * lane + 256 * j); s += (v[j][0] + v[j][1]) + (v[j][2] + v[j][3]); }
            const float mean = wave_sum(s) * (1.0f / D); float q = 0.f;
#pragma unroll
            for (int j = 0; j < 8; ++j) { v[j] = v[j] - mean; q += (v[j][0] * v[j][0] + v[j][1] * v[j][1]) + (v[j][2] * v[j][2] + v[j][3] * v[j][3]); }
            const float rstd = 1.0f / sqrtf(wave_sum(q) * (1.0f / D) + LN_EPS);
#pragma unroll
            for (int j = 0; j < 8; ++j) { const int col = 4 * lane + 256 * j; const f32x4 x = v[j] * rstd * g[j] + bb[j]; *(f32x4*)(X + row * D + col) = x;
                if (has_u) { const f32x4 u = x * sc[j] + sh[j]; u32x2 w; w.x = pkh(u[0], u[1]); w.y = pkh(u[2], u[3]); *(u32x2*)(U + row * D + col) = w; } }
        }
    }
}

constexpr int GL_ZL = 0, GL_WG = 4096, GL_LA = 12288, GL_QD = 45056, GL_KI = 62464, GL_V = 79872, GL_QS = 272, GL_VS = 576;
__device__ __forceinline__ void gla_chunk_unit(Ctx& F, int e, int c, int h) {
    const int tid = launder(F.tid), lane = tid & 63, w = F.wave;
    LAS unsigned char* lds = F.lds;
    const h16_t* Z = (const h16_t*)(F.ws + WS_Z);
    const size_t row0 = (size_t)c * CH;
    if (tid < 128) { const int i = tid >> 1, hf = tid & 1; const h16x8 z = *(const h16x8*)(Z + (row0 + i) * P_PAD + OFF_LR + 8 * hf);
        LAS float* d = (LAS float*)(lds + GL_ZL) + i * 16 + 8 * hf;
#pragma unroll
        for (int k = 0; k < 8; ++k) d[k] = (float)z[k]; }
    { const int r = tid >> 5, d4 = (tid & 31) * 4; *(LAS f32x4*)(lds + GL_WG + (r * 128 + d4) * 4) = *(const f32x4*)(F.in[I_WGLR] + ((size_t)e * GRANK + r) * (GH * GDK) + h * GDK + d4); }
#pragma unroll
    for (int k = 0; k < 4; ++k) { const int q = tid + 512 * k, j = q >> 5, ch = q & 31;
        *(LAS u32x4*)(lds + GL_V + j * GL_VS + ch * 16) = *(const u32x4*)(Z + (row0 + j) * P_PAD + OFF_V + h * GDV + ch * 8); }
    __syncthreads();
    { const int d = tid & 127, i0 = tid >> 7; float wg[16];
#pragma unroll
        for (int r = 0; r < 16; ++r) wg[r] = *(LAS float*)(lds + GL_WG + (r * 128 + d) * 4);
        const float bg = F.in[I_BGATE][(size_t)e * (GH * GDK) + h * GDK + d];
#pragma unroll 4
        for (int k = 0; k < 16; ++k) { const int i = i0 + 4 * k; const LAS float* zl = (const LAS float*)(lds + GL_ZL) + i * 16; float s = bg;
#pragma unroll
            for (int r = 0; r < 16; ++r) s += zl[r] * wg[r];
            *(LAS float*)(lds + GL_LA + (i * 128 + d) * 4) = log_sigmoid(s) * (1.0f / 16.0f); } }
    __syncthreads();
    if (tid < 128) { LAS float* p = (LAS float*)(lds + GL_LA) + tid; float v[64];
#pragma unroll
        for (int i = 0; i < 64; ++i) v[i] = p[i * 128];
        float s = 0.f;
#pragma unroll
        for (int i = 0; i < 64; ++i) { s += v[i]; p[i * 128] = s; } }
    __syncthreads();
    { const int i = tid >> 3, d0 = (tid & 7) * 16;
        h16_t* QDg = (h16_t*)(F.ws + WS_QD) + (row0 + i) * (GH * GDK) + h * GDK + d0; h16_t* KDg = (h16_t*)(F.ws + WS_KD) + (row0 + i) * (GH * GDK) + h * GDK + d0;
#pragma unroll
        for (int hf = 0; hf < 2; ++hf) { const int d = d0 + 8 * hf;
            const h16x8 q = *(const h16x8*)(Z + (row0 + i) * P_PAD + OFF_Q + h * GDK + d), k = *(const h16x8*)(Z + (row0 + i) * P_PAD + OFF_K + h * GDK + d);
            float qd[8], ki[8], kd[8];
#pragma unroll
            for (int x = 0; x < 8; ++x) { const float bcur = *(LAS float*)(lds + GL_LA + (i * 128 + d + x) * 4), bl = *(LAS float*)(lds + GL_LA + (63 * 128 + d + x) * 4);
                qd[x] = (float)q[x] * 0.08838834764831845f * __expf(bcur); ki[x] = (float)k[x] * __expf(-bcur); kd[x] = (float)k[x] * __expf(bl - bcur);
                if (i == 63) ((float*)(F.ws + WS_DEC))[(size_t)c * (GH * GDK) + h * GDK + d + x] = __expf(bl); }
            const h16x8 qv = pack8(qd[0], qd[1], qd[2], qd[3], qd[4], qd[5], qd[6], qd[7]), kiv = pack8(ki[0], ki[1], ki[2], ki[3], ki[4], ki[5], ki[6], ki[7]), kdv = pack8(kd[0], kd[1], kd[2], kd[3], kd[4], kd[5], kd[6], kd[7]);
            *(LAS h16x8*)(lds + GL_QD + i * GL_QS + d * 2) = qv; *(LAS h16x8*)(lds + GL_KI + i * GL_QS + d * 2) = kiv;
            *(h16x8*)(QDg + 8 * hf) = qv; *(h16x8*)(KDg + 8 * hf) = kdv; } }
    __syncthreads();
    { const int qb = w & 1, vt0 = (w >> 1) * 2, l31 = lane & 31, hh = lane >> 5;
        f32x16 st[2];
#pragma unroll
        for (int jb = 0; jb < 2; ++jb) { st[jb] = (f32x16){};
            if (jb <= qb) {
#pragma unroll
                for (int ks = 0; ks < 8; ++ks) { const h16x8 a = *(const LAS h16x8*)(lds + GL_KI + (32 * jb + l31) * GL_QS + (16 * ks + 8 * hh) * 2), bq = *(const LAS h16x8*)(lds + GL_QD + (32 * qb + l31) * GL_QS + (16 * ks + 8 * hh) * 2);
                    st[jb] = __builtin_amdgcn_mfma_f32_32x32x16_f16(a, bq, st[jb], 0, 0, 0); } } }
        h16x8 pk[2][2];
#pragma unroll
        for (int jb = 0; jb < 2; ++jb)
#pragma unroll
            for (int s = 0; s < 2; ++s) { float p[8];
#pragma unroll
                for (int x = 0; x < 8; ++x) { const int r = 8 * s + x; const int key = 32 * jb + (r & 3) + 8 * (r >> 2) + 4 * hh, qi = 32 * qb + l31; p[x] = key <= qi ? st[jb][r] : 0.f; }
                pk[jb][s] = pack8(p[0], p[1], p[2], p[3], p[4], p[5], p[6], p[7]); }
        const int i16 = lane & 15, q4 = i16 >> 2, p4 = i16 & 3;
        float* OI = (float*)(F.ws + WS_OI);
#pragma unroll
        for (int vi = 0; vi < 2; ++vi) { const int vt = vt0 + vi; f32x16 o = (f32x16){};
#pragma unroll
            for (int jb = 0; jb < 2; ++jb)
#pragma unroll
                for (int s = 0; s < 2; ++s) { if (jb > qb) continue;
                    const LAS unsigned char* p = lds + GL_V + (32 * jb + 16 * s + 4 * hh + q4) * GL_VS + (32 * vt + 16 * ((lane >> 4) & 1) + 4 * p4) * 2;
                    const h16x8 a = tr_pair(p, 8 * GL_VS);
                    o = __builtin_amdgcn_mfma_f32_32x32x16_f16(a, pk[jb][s], o, 0, 0, 0); }
            float* op = OI + (row0 + 32 * qb + l31) * (GH * GDV) + h * GDV + 32 * vt + 4 * hh;
#pragma unroll
            for (int rg = 0; rg < 4; ++rg) *(f32x4*)(op + 8 * rg) = (f32x4){o[4 * rg], o[4 * rg + 1], o[4 * rg + 2], o[4 * rg + 3]}; }
    }
    __syncthreads();
}
__device__ __forceinline__ void pool_d_item(Ctx& F, int item) {
    const int tid = launder(F.tid); const int run = item * 4 + (tid >> 7), c8 = (tid & 127) * 8, gi = c8 >> 8, wlen = 2 << gi;
    const h16_t* Z = (const h16_t*)(F.ws + WS_Z); h16_t* DP = (h16_t*)(F.ws + WS_DP);
    const int r0 = run * 32; const int pos0 = r0 & (SEQ - 1);
    float S[8];
#pragma unroll
    for (int x = 0; x < 8; ++x) S[x] = 0.f;
    for (int j = 1; j < wlen; ++j) if (pos0 - j >= 0) { const h16x8 z = *(const h16x8*)(Z + (size_t)(r0 - j) * P_PAD + c8);
#pragma unroll
        for (int x = 0; x < 8; ++x) S[x] += (float)z[x]; }
#pragma unroll 4
    for (int r = 0; r < 32; ++r) { const int row = r0 + r, pos = pos0 + r; const h16x8 z = *(const h16x8*)(Z + (size_t)row * P_PAD + c8);
        const float inv = 1.0f / (float)(pos + 1 < wlen ? pos + 1 : wlen); float dv[8];
#pragma unroll
        for (int x = 0; x < 8; ++x) { S[x] += (float)z[x]; dv[x] = S[x] * inv - (float)z[x]; }
        *(h16x8*)(DP + (size_t)row * PW + c8) = pack8(dv[0], dv[1], dv[2], dv[3], dv[4], dv[5], dv[6], dv[7]);
        if (pos - (wlen - 1) >= 0) { const h16x8 zo = *(const h16x8*)(Z + (size_t)(row - (wlen - 1)) * P_PAD + c8);
#pragma unroll
            for (int x = 0; x < 8; ++x) S[x] -= (float)zo[x]; } }
}
__device__ __forceinline__ void step_even_a(Ctx& F, int e) {
    for (int it = F.bid; it < M / 128; it += F.G) pool_d_item(F, it);
    for (int u = F.bid; u < NCHUNK * GH; u += F.G) gla_chunk_unit(F, e, u >> 2, u & 3);
}

constexpr int SC_QD = 0, SC_KD = 17408, SC_V = 37888, SC_DEC = 58368, SC_BUF = 58880, SC_QS = 272, SC_KS = 320;
__device__ __forceinline__ void scan_unit(Ctx& F, int wg) {
    const int tid = launder(F.tid), lane = tid & 63, w = F.wave;
    const int b = wg >> 3, h = (wg >> 1) & 3, vh = wg & 1;
    LAS unsigned char* lds = F.lds;
    const h16_t* Z = (const h16_t*)(F.ws + WS_Z); const h16_t* QDg = (const h16_t*)(F.ws + WS_QD); const h16_t* KDg = (const h16_t*)(F.ws + WS_KD);
    const float* DEC = (const float*)(F.ws + WS_DEC); float* OI = (float*)(F.ws + WS_OI);
    const int g = lane >> 4, l15 = lane & 15, q4 = l15 >> 2, p4 = l15 & 3;
    f32x4 st[8];
#pragma unroll
    for (int T = 0; T < 8; ++T) st[T] = (f32x4){0.f, 0.f, 0.f, 0.f};
    u32x4 rq[2], rk[2], rv[2]; float rd = 0.f;
    auto gload = [&](int n) {
        const size_t row0 = (size_t)b * SEQ + (size_t)n * CH;
#pragma unroll
        for (int k = 0; k < 2; ++k) { const int q = tid + 512 * k, j = q >> 4, ch = q & 15;
            rq[k] = *(const u32x4*)(QDg + (row0 + j) * (GH * GDK) + h * GDK + ch * 8);
            rk[k] = *(const u32x4*)(KDg + (row0 + j) * (GH * GDK) + h * GDK + ch * 8);
            rv[k] = *(const u32x4*)(Z + (row0 + j) * P_PAD + OFF_V + h * GDV + vh * 128 + ch * 8); }
        if (tid < 128) rd = DEC[((size_t)b * CPS + n) * (GH * GDK) + h * GDK + tid];
    };
    auto lstore = [&](int buf) {
        LAS unsigned char* B = lds + buf * SC_BUF;
#pragma unroll
        for (int k = 0; k < 2; ++k) { const int q = tid + 512 * k, j = q >> 4, ch = q & 15;
            *(LAS u32x4*)(B + SC_QD + j * SC_QS + ch * 16) = rq[k]; *(LAS u32x4*)(B + SC_KD + j * SC_KS + ch * 16) = rk[k]; *(LAS u32x4*)(B + SC_V + j * SC_KS + ch * 16) = rv[k]; }
        if (tid < 128) *(LAS float*)(B + SC_DEC + tid * 4) = rd;
    };
    gload(0); lstore(0); __syncthreads();
    for (int n = 0; n < CPS; ++n) {
        const LAS unsigned char* B = lds + (n & 1) * SC_BUF;
        if (n + 1 < CPS) gload(n + 1);
        const size_t row0 = (size_t)b * SEQ + (size_t)n * CH;
        const int vcol = h * GDV + vh * 128 + w * 16 + l15;
        float oi[4][4];
#pragma unroll
        for (int it = 0; it < 4; ++it)
#pragma unroll
            for (int r = 0; r < 4; ++r) oi[it][r] = OI[(row0 + 16 * it + 4 * g + r) * (GH * GDV) + vcol];
        h16x8 sb[4];
#pragma unroll
        for (int ks = 0; ks < 4; ++ks) sb[ks] = pack8(st[2 * ks][0], st[2 * ks][1], st[2 * ks][2], st[2 * ks][3], st[2 * ks + 1][0], st[2 * ks + 1][1], st[2 * ks + 1][2], st[2 * ks + 1][3]);
#pragma unroll
        for (int it = 0; it < 4; ++it) { f32x4 acc = (f32x4){0.f, 0.f, 0.f, 0.f};
#pragma unroll
            for (int ks = 0; ks < 4; ++ks) { const LAS unsigned char* qp = B + SC_QD + (16 * it + l15) * SC_QS + (32 * ks + 4 * g) * 2;
                const u32x2 lo = *(const LAS u32x2*)qp, hi = *(const LAS u32x2*)(qp + 32);
                const u32x4 aw = {lo.x, lo.y, hi.x, hi.y};
                acc = __builtin_amdgcn_mfma_f32_16x16x32_f16(__builtin_bit_cast(h16x8, aw), sb[ks], acc, 0, 0, 0); }
#pragma unroll
            for (int r = 0; r < 4; ++r) OI[(row0 + 16 * it + 4 * g + r) * (GH * GDV) + vcol] = oi[it][r] + acc[r]; }
        h16x8 bv[2];
#pragma unroll
        for (int js = 0; js < 2; ++js) bv[js] = tr_pair(B + SC_V + (32 * js + 8 * g + q4) * SC_KS + (16 * w + 4 * p4) * 2, 4 * SC_KS);
#pragma unroll
        for (int T = 0; T < 8; ++T) { const f32x4 dc = *(const LAS f32x4*)(B + SC_DEC + (16 * T + 4 * g) * 4); st[T] = st[T] * dc;
#pragma unroll
            for (int js = 0; js < 2; ++js) { const h16x8 a = tr_pair(B + SC_KD + (32 * js + 8 * g + q4) * SC_KS + (16 * T + 4 * p4) * 2, 4 * SC_KS);
                st[T] = __builtin_amdgcn_mfma_f32_16x16x32_f16(a, bv[js], st[T], 0, 0, 0); } }
        if (n + 1 < CPS) lstore((n + 1) & 1);
        __syncthreads();
    }
}

__device__ __forceinline__ void step_even_c(Ctx& F, int e) {
    const int gw = F.bid * NWAVES + F.wave, NGW = F.G * NWAVES, lane = launder(F.lane);
    const float* OI = (const float*)(F.ws + WS_OI); const h16_t* Z = (const h16_t*)(F.ws + WS_Z); h16_t* Y = (h16_t*)(F.ws + WS_Y);
    f32x4 gn[4];
#pragma unroll
    for (int hh = 0; hh < 4; ++hh) gn[hh] = *(const f32x4*)(F.in[I_GNG] + (size_t)e * (GH * GDV) + hh * GDV + 4 * lane);
    for (int row = gw; row < M; row += NGW) {
#pragma unroll
        for (int hh = 0; hh < 4; ++hh) { const int col = hh * GDV + 4 * lane;
            f32x4 o = *(const f32x4*)(OI + (size_t)row * (GH * GDV) + col);
            const float mean = wave_sum((o[0] + o[1]) + (o[2] + o[3])) * (1.0f / GDV); o = o - mean;
            const float var = wave_sum((o[0] * o[0] + o[1] * o[1]) + (o[2] * o[2] + o[3] * o[3])) * (1.0f / GDV);
            const float rstd = 1.0f / sqrtf(var + LN_EPS);
            const h16x4 r = *(const h16x4*)(Z + (size_t)row * P_PAD + OFF_R + col);
            float y[4];
#pragma unroll
            for (int x = 0; x < 4; ++x) { const float rr = (float)r[x]; y[x] = rr * sigmoidf_(rr) * (o[x] * rstd * gn[hh][x]); }
            u32x2 wv; wv.x = pkh(y[0], y[1]); wv.y = pkh(y[2], y[3]); *(u32x2*)(Y + (size_t)row * D + PW + col) = wv; }
    }
}

constexpr int AT_K = 0, AT_V = 34816, AT_BIAS = 75776, AT_KS = 272, AT_VS = 320, AT_KH = 64 * 272, AT_VH = 64 * 320;
__device__ __forceinline__ void attn_unit(Ctx& F, int o, int b, int hp, int cp) {
    const int tid = launder(F.tid), lane = tid & 63, w = F.wave;
    LAS unsigned char* lds = F.lds;
    const h16_t* QKV = (const h16_t*)(F.ws + WS_Z); h16_t* Y = (h16_t*)(F.ws + WS_Y);
    const int hl = w >> 2, cl = (w >> 1) & 1, qh = w & 1, h = 2 * hp + hl, c = 2 * cp + cl;
    const int l31 = lane & 31, hh = lane >> 5;
    const size_t qrow = (size_t)b * SEQ + (size_t)c * CH + 32 * qh + l31;
    for (int i = tid; i < 2 * 513; i += NTHR) { const int t = i / 513, k = i % 513; *(LAS float*)(lds + AT_BIAS + (t * 516 + k) * 4) = F.in[I_RELB][((size_t)o * AH + 2 * hp + t) * 513 + k]; }
    h16x8 qf[8];
#pragma unroll
    for (int ks = 0; ks < 8; ++ks) qf[ks] = *(const h16x8*)(QKV + qrow * NQKV + h * ADH + 16 * ks + 8 * hh);
    f32x16 oacc[4];
#pragma unroll
    for (int dt = 0; dt < 4; ++dt) oacc[dt] = (f32x16){};
    float mrun = -1e30f, lrun = 0.f;
    const float sc2 = 0.08838834764831845f * 1.4426950408889634f;
    u32x4 rk[4], rv[4];
    auto gload = [&](int jt) {
        const size_t krow0 = (size_t)b * SEQ + (size_t)(2 * cp - 8 + jt) * CH;
#pragma unroll
        for (int k = 0; k < 4; ++k) { const int q = tid + 512 * k, t = q >> 10, j = (q >> 4) & 63, ch = q & 15; const size_t base = (krow0 + j) * NQKV + (2 * hp + t) * ADH + ch * 8;
            rk[k] = *(const u32x4*)(QKV + base + D); rv[k] = *(const u32x4*)(QKV + base + 2 * D); }
    };
    auto lstore = [&]() {
#pragma unroll
        for (int k = 0; k < 4; ++k) { const int q = tid + 512 * k, t = q >> 10, j = (q >> 4) & 63, ch = q & 15;
            *(LAS u32x4*)(lds + AT_K + t * AT_KH + j * AT_KS + ch * 16) = rk[k]; *(LAS u32x4*)(lds + AT_V + t * AT_VH + j * AT_VS + ch * 16) = rv[k]; }
    };
    const int jt0 = (8 - 2 * cp) > 0 ? (8 - 2 * cp) : 0;
    gload(jt0); lstore(); __syncthreads();
    const int i16 = lane & 15, q4 = i16 >> 2, p4 = i16 & 3;
    for (int jt = jt0; jt < 10; ++jt) {
        if (jt + 1 < 10) gload(jt + 1);
        if (jt >= cl && jt <= cl + 8) {
            const int dchunk = cl + 8 - jt;
            f32x16 s[2];
#pragma unroll
            for (int kb = 0; kb < 2; ++kb) { s[kb] = (f32x16){};
#pragma unroll
                for (int ks = 0; ks < 8; ++ks) { const h16x8 a = *(const LAS h16x8*)(lds + AT_K + hl * AT_KH + (32 * kb + l31) * AT_KS + (16 * ks + 8 * hh) * 2);
                    s[kb] = __builtin_amdgcn_mfma_f32_32x32x16_f16(a, qf[ks], s[kb], 0, 0, 0); } }
            const LAS float* bt = (const LAS float*)(lds + AT_BIAS) + hl * 516;
            float mx = -1e30f;
#pragma unroll
            for (int kb = 0; kb < 2; ++kb)
#pragma unroll
                for (int r = 0; r < 16; ++r) { const int key = 32 * kb + (r & 3) + 8 * (r >> 2) + 4 * hh; int dq = dchunk * 64 + (32 * qh + l31) - key; dq = dq > 256 ? 256 : dq;
                    const float v = s[kb][r] * sc2 + bt[dq + 256] * 1.4426950408889634f; s[kb][r] = v; mx = fmaxf(mx, v); }
            mx = fmaxf(mx, __shfl_xor(mx, 32));
            const float mnew = fmaxf(mrun, mx), alpha = __builtin_amdgcn_exp2f(mrun - mnew); mrun = mnew;
            float ps = 0.f; h16x8 pk[2][2];
#pragma unroll
            for (int kb = 0; kb < 2; ++kb)
#pragma unroll
                for (int sx = 0; sx < 2; ++sx) { float p[8];
#pragma unroll
                    for (int x = 0; x < 8; ++x) { p[x] = __builtin_amdgcn_exp2f(s[kb][8 * sx + x] - mnew); ps += p[x]; }
                    pk[kb][sx] = pack8(p[0], p[1], p[2], p[3], p[4], p[5], p[6], p[7]); }
            lrun = lrun * alpha + ps;
#pragma unroll
            for (int dt = 0; dt < 4; ++dt) { oacc[dt] = oacc[dt] * alpha;
#pragma unroll
                for (int kb = 0; kb < 2; ++kb)
#pragma unroll
                    for (int sx = 0; sx < 2; ++sx) { const LAS unsigned char* p = lds + AT_V + hl * AT_VH + (32 * kb + 16 * sx + 4 * hh + q4) * AT_VS + (32 * dt + 16 * ((lane >> 4) & 1) + 4 * p4) * 2;
                        oacc[dt] = __builtin_amdgcn_mfma_f32_32x32x16_f16(tr_pair(p, 8 * AT_VS), pk[kb][sx], oacc[dt], 0, 0, 0); } }
        }
        __syncthreads();
        if (jt + 1 < 10) { lstore(); __syncthreads(); }
    }
    const float ltot = lrun + __shfl_xor(lrun, 32), inv = 1.0f / ltot;
    h16_t* yp = Y + qrow * D + h * ADH + 4 * hh;
#pragma unroll
    for (int dt = 0; dt < 4; ++dt)
#pragma unroll
        for (int rg = 0; rg < 4; ++rg) { u32x2 wv; wv.x = pkh(oacc[dt][4 * rg] * inv, oacc[dt][4 * rg + 1] * inv); wv.y = pkh(oacc[dt][4 * rg + 2] * inv, oacc[dt][4 * rg + 3] * inv);
            *(u32x2*)(yp + 32 * dt + 8 * rg) = wv; }
    __syncthreads();
}
__device__ __forceinline__ void step_attn(Ctx& F, int o) {
    for (int u = F.bid; u < NB * 8 * 64; u += F.G) { const int cp = u & 63, hp = (u >> 6) & 7, b = u >> 9; attn_unit(F, o, b, hp, cp); }
}

__device__ __forceinline__ void step_ffn_fix(Ctx& F, int l) {
    const float* rawg = (const float*)(F.ws + WS_RAWG); const float* rawa = (const float*)(F.ws + WS_RAWA); h16_t* H = (h16_t*)(F.ws + WS_H);
    const float* cw = F.in[I_CONVW] + (size_t)l * 3 * FF; const float* cb = F.in[I_CONVB] + (size_t)l * FF;
    for (int idx = F.bid * NTHR + launder(F.tid); idx < (M / 64) * (FF / 4); idx += F.G * NTHR) {
        const int blk = idx / (FF / 4), j = (idx % (FF / 4)) * 4;
        const bool first = (blk % CPS) == 0;
        const f32x4 z4 = {0.f, 0.f, 0.f, 0.f};
        const f32x4 gm2 = first ? z4 : *(const f32x4*)(rawg + ((size_t)(blk - 1) * 4 + 2) * FF + j), gm1 = first ? z4 : *(const f32x4*)(rawg + ((size_t)(blk - 1) * 4 + 3) * FF + j);
        const f32x4 g0 = *(const f32x4*)(rawg + ((size_t)blk * 4 + 0) * FF + j), g1 = *(const f32x4*)(rawg + ((size_t)blk * 4 + 1) * FF + j);
        const f32x4 a0 = *(const f32x4*)(rawa + ((size_t)blk * 2 + 0) * FF + j), a1 = *(const f32x4*)(rawa + ((size_t)blk * 2 + 1) * FF + j);
        const f32x4 w0 = *(const f32x4*)(cw + j), w1 = *(const f32x4*)(cw + FF + j), w2 = *(const f32x4*)(cw + 2 * FF + j), bb = *(const f32x4*)(cb + j);
        float r0[4], r1[4];
#pragma unroll
        for (int x = 0; x < 4; ++x) { r0[x] = gelu_tanh(bb[x] + w0[x] * gm2[x] + w1[x] * gm1[x] + w2[x] * g0[x]) * a0[x]; r1[x] = gelu_tanh(bb[x] + w0[x] * gm1[x] + w1[x] * g0[x] + w2[x] * g1[x]) * a1[x]; }
        u32x2 v0, v1; v0.x = pkh(r0[0], r0[1]); v0.y = pkh(r0[2], r0[3]); v1.x = pkh(r1[0], r1[1]); v1.y = pkh(r1[2], r1[3]);
        *(u32x2*)(H + (size_t)(blk * 64) * FF + j) = v0; *(u32x2*)(H + (size_t)(blk * 64 + 1) * FF + j) = v1;
    }
}

constexpr int NSTEPS = 2 + 10 * DEPTH;
struct Args { const float* in[20]; float* out; unsigned char* ws; int s_lo, s_hi; };

__global__ void __launch_bounds__(NTHR, 2) mk_fwd(Args args) {
    extern __shared__ __attribute__((aligned(16))) unsigned char lds_raw[];
    Ctx F;
    F.lds = (LAS unsigned char*)lds_raw;
    F.tid = threadIdx.x; F.lane = F.tid & 63; F.wave = __builtin_amdgcn_readfirstlane(F.tid >> 6); F.G = gridDim.x; F.bid = blockIdx.x;
#pragma unroll
    for (int i = 0; i < 20; ++i) F.in[i] = args.in[i];
    F.out = args.out; F.ws = args.ws;
    unsigned* ctl = (unsigned*)(F.ws + WS_CTL);
    for (int u = F.tid; u < (LDS_BYTES - LDSCTL_OFF) / 4; u += NTHR) ((LAS unsigned*)(F.lds + LDSCTL_OFF))[u] = 0u;
    __syncthreads();
    volatile LAS unsigned* MISC = (volatile LAS unsigned*)(F.lds + MISC_OFF);
    const bool multi = (args.s_hi - args.s_lo) > 1;
    XcdBarrier bar; bar.bar = ctl + CW_BAR; bar.x = 0; bar.st = MISC + 8;
    if (multi) bar = xcd_barrier_post(ctl + CW_BAR, MISC + 8);
    const int lo = args.s_lo, hi = args.s_hi;
    bool need_bar = false;
#define STEP_BEGIN(s, bit) if (MKM(bit) && lo <= (s) && (s) < hi) { if (need_bar) xcd_barrier(bar); need_bar = true;
#define STEP_END }
    STEP_BEGIN(0, 0) step_prologue(F); STEP_END
    STEP_BEGIN(1, 1) step_mod_u0(F); STEP_END
    const float* mod = (const float*)(F.ws + WS_MOD);
    for (int l = 0; l < DEPTH; ++l) {
        const int s0 = 2 + 10 * l; const bool even = (l & 1) == 0; const int eo = l >> 1;
        STEP_BEGIN(s0 + 0, 2) {
            pg8::Gemm g; g.A = (const h16_t*)(F.ws + WS_U); g.lda = D; g.K = D; g.akoff = 0; g.ldb = D;
            int N;
            if (even) { g.Bt = (const h16_t*)(F.ws + WS_WIN) + (size_t)eo * P_PAD * D; N = P_PAD; } else { g.Bt = (const h16_t*)(F.ws + WS_WQKV) + (size_t)eo * NQKV * D; N = NQKV; }
            pg8::StaticOrder S; S.init(M, N, F.G, F.bid);
            pg8::EpiStoreH E{(h16_t*)(F.ws + WS_Z), N, nullptr};
            pg8::gemm_phase(F.lds, g, S, E);
        } STEP_END
        STEP_BEGIN(s0 + 1, 3) if (even) { if (MKM(12)) step_even_a(F, eo); } else { if (MKM(13)) step_attn(F, eo); } STEP_END
        if (even) { STEP_BEGIN(s0 + 2, 4) {
            if (F.bid < 32) { if (MKM(14)) scan_unit(F, F.bid); }
            else if (MKM(15)) { pg8::Gemm g; g.A = (const h16_t*)(F.ws + WS_DP); g.lda = PW; g.K = PGRP; g.akoff = PGRP; g.Bt = (const h16_t*)(F.ws + WS_WPOOL) + (size_t)eo * PW * PGRP; g.ldb = PGRP;
                pg8::StaticOrder S; S.init(M, PW, F.G - 32, F.bid - 32);
                pg8::EpiStoreH E{(h16_t*)(F.ws + WS_Y), D, F.in[I_PSCALE] + (size_t)eo * PW};
                pg8::gemm_phase(F.lds, g, S, E); }
        } STEP_END
        STEP_BEGIN(s0 + 3, 5) step_even_c(F, eo); STEP_END }
        STEP_BEGIN(s0 + 4, 6) {
            pg8::Gemm g; g.A = (const h16_t*)(F.ws + WS_Y); g.lda = D; g.K = D; g.akoff = 0; g.ldb = D;
            g.Bt = even ? (const h16_t*)(F.ws + WS_WOUT) + (size_t)eo * D * D : (const h16_t*)(F.ws + WS_WO) + (size_t)eo * D * D;
            pg8::StaticOrder S; S.init(M, D, F.G, F.bid);
            pg8::EpiResid E{l == 0 ? F.in[I_X] : F.out, F.out, mod + (size_t)l * NB * MODW + 2 * D};
            pg8::gemm_phase(F.lds, g, S, E);
        } STEP_END
        STEP_BEGIN(s0 + 5, 7) step_ln(F, l, 0); STEP_END
        STEP_BEGIN(s0 + 6, 8) {
            pg8::Gemm g; g.A = (const h16_t*)(F.ws + WS_U); g.lda = D; g.K = D; g.akoff = 0; g.ldb = D; g.Bt = (const h16_t*)(F.ws + WS_WUP) + (size_t)l * NUP * D;
            pg8::StaticOrder S; S.init(M, NUP, F.G, F.bid);
            pg8::EpiFFN E{(h16_t*)(F.ws + WS_H), F.in[I_CONVW] + (size_t)l * 3 * FF, F.in[I_CONVB] + (size_t)l * FF, (float*)(F.ws + WS_RAWG), (float*)(F.ws + WS_RAWA)};
            pg8::gemm_phase(F.lds, g, S, E);
        } STEP_END
        STEP_BEGIN(s0 + 7, 9) step_ffn_fix(F, l); STEP_END
        STEP_BEGIN(s0 + 8, 10) {
            pg8::Gemm g; g.A = (const h16_t*)(F.ws + WS_H); g.lda = FF; g.K = FF; g.akoff = 0; g.ldb = FF; g.Bt = (const h16_t*)(F.ws + WS_WDN) + (size_t)l * D * FF;
            pg8::StaticOrder S; S.init(M, D, F.G, F.bid);
            pg8::EpiResid E{F.out, F.out, mod + (size_t)l * NB * MODW + 5 * D};
            pg8::gemm_phase(F.lds, g, S, E);
        } STEP_END
        STEP_BEGIN(s0 + 9, 11) step_ln(F, l, 1); STEP_END
    }
#undef STEP_BEGIN
#undef STEP_END
}

#if MK_DEBUG
__device__ __forceinline__ void dbg_fail(unsigned* ctl, int step, float got, float want) {
    if (atomicCAS(ctl + CW_ERR, 0u, (unsigned)(step + 1)) == 0u) { ((float*)ctl)[CW_ERRV] = got; ((float*)ctl)[CW_ERRV + 1] = want; }
}
__device__ __forceinline__ bool dbg_bad(float got, float want, float scale) { const float d = fabsf(got - want); return !(d <= 0.03f * (fabsf(want) + scale)); }
__device__ __forceinline__ unsigned dbg_hash(unsigned x) { x ^= x >> 16; x *= 0x7feb352dU; x ^= x >> 15; x *= 0x846ca68bU; x ^= x >> 16; return x; }
__device__ __forceinline__ float dbg_dot(const h16_t* A, size_t lda, size_t row, int acol0, int K, const float* W, size_t ldw, int wcol, int lane) {
    float s = 0.f;
    for (int k = lane; k < K; k += 64) s += h2f(A[row * lda + acol0 + k]) * h2f(f2h(W[(size_t)k * ldw + wcol]));
    return wave_sum(s);
}
__device__ __forceinline__ int dbg_row(unsigned hsh, int i) {
    const int sel = i & 7; int r = (int)(hsh % (unsigned)M);
    if (sel == 0) r = (r & ~(SEQ - 1)) + (int)((hsh >> 20) & 3);
    else if (sel == 1) r = (r & ~63) + (int)((hsh >> 20) & 3);
    else if (sel == 2) r = (r & ~63) + 60 + (int)((hsh >> 20) & 3);
    return r;
}
__global__ void __launch_bounds__(NTHR, 2) mk_check(Args args, int step) {
    const int tid = threadIdx.x, lane = tid & 63, gw = blockIdx.x * NWAVES + (tid >> 6), NGW = gridDim.x * NWAVES;
    unsigned char* ws = args.ws; unsigned* ctl = (unsigned*)(ws + WS_CTL);
    const float* mod = (const float*)(ws + WS_MOD);
    const float* XD = (const float*)(ws + WS_DBG);
    const h16_t* U = (const h16_t*)(ws + WS_U); const h16_t* Z = (const h16_t*)(ws + WS_Z); const h16_t* Y = (const h16_t*)(ws + WS_Y); const h16_t* H = (const h16_t*)(ws + WS_H);
    const int NS = 4096;
    if (step == 1) {
        for (int i = gw; i < NS; i += NGW) { const unsigned hs = dbg_hash(i * 2654435761u + 17u); const int l = hs & 3, b = (hs >> 2) & 3, n = (hs >> 4) % MODW;
            float s = 0.f; for (int k = lane; k < D; k += 64) { const float c = args.in[I_C][b * D + k]; s += c / (1.f + expf(-c)) * args.in[I_WADA][((size_t)l * D + k) * MODW + n]; }
            s = wave_sum(s) + args.in[I_BADA][l * MODW + n]; const float got = mod[((size_t)l * NB + b) * MODW + n];
            if (lane == 0 && dbg_bad(got, s, 0.05f)) dbg_fail(ctl, step, got, s); }
        for (int i = gw; i < NS; i += NGW) { const unsigned hs = dbg_hash(i * 2654435761u + 99u); const int row = hs % M, col = (hs >> 8) % D, b = row / SEQ;
            const float want = args.in[I_X][(size_t)row * D + col] * (1.f + mod[(size_t)b * MODW + D + col]) + mod[(size_t)b * MODW + col]; const float got = h2f(U[(size_t)row * D + col]);
            if (lane == 0 && dbg_bad(got, want, 0.05f)) dbg_fail(ctl, step, got, want); }
        return;
    }
    if (step < 2) return;
    const int l = (step - 2) / 10, k = (step - 2) % 10, eo = l >> 1; const bool even = (l & 1) == 0;
    if (k == 0) {
        for (int i = gw; i < NS; i += NGW) { const unsigned hs = dbg_hash(i * 2654435761u + step); const int row = dbg_row(hs, i); const int N = even ? P_AB : NQKV; int col = (hs >> 3) % N; if (even && (i & 15) == 5) col = OFF_LR + (hs & 15);
            const float want = dbg_dot(U, D, row, 0, D, even ? args.in[I_WIN] + (size_t)eo * D * P_AB : args.in[I_WQKV] + (size_t)eo * D * NQKV, N, col, lane);
            const float got = h2f(Z[(size_t)row * (even ? P_PAD : NQKV) + col]);
            if (lane == 0 && dbg_bad(got, want, 0.3f)) dbg_fail(ctl, step, got, want); }
    } else if (k == 1 && even) {
        const h16_t* DP = (const h16_t*)(ws + WS_DP);
        for (int i = gw * 64 + lane; i < NS * 16; i += NGW * 64) { const unsigned hs = dbg_hash(i * 2654435761u + step); const int row = dbg_row(hs, i), col = (hs >> 5) % PW, wl = 2 << (col >> 8), pos = row % SEQ;
            float s = 0.f; int cnt = 0; for (int j = 0; j < wl; ++j) if (pos - j >= 0) { s += h2f(Z[(size_t)(row - j) * P_PAD + col]); ++cnt; }
            const float want = s / cnt - h2f(Z[(size_t)row * P_PAD + col]); const float got = h2f(DP[(size_t)row * PW + col]);
            if (dbg_bad(got, want, 0.2f)) dbg_fail(ctl, step, got, want); }
    } else if (k == 1 && !even) {
        for (int i = gw; i < NS / 4; i += NGW) { const unsigned hs = dbg_hash(i * 2654435761u + step); const int row = dbg_row(hs, i), h = (hs >> 7) & 15, dd = (hs >> 11) & 127;
            const int b = row / SEQ, pos = row % SEQ, c = pos / CH; const int k0 = (c - 8) * CH > 0 ? (c - 8) * CH : 0, k1 = (c + 1) * CH;
            float mx = -1e30f;
            for (int kp = k0 + lane; kp < k1; kp += 64) { float s = 0.f; for (int d = 0; d < ADH; ++d) s += h2f(Z[(size_t)row * NQKV + h * ADH + d]) * h2f(Z[((size_t)b * SEQ + kp) * NQKV + D + h * ADH + d]);
                int dq = pos - kp; dq = dq > 256 ? 256 : (dq < -256 ? -256 : dq); s = s * 0.08838834764831845f + args.in[I_RELB][((size_t)eo * AH + h) * 513 + dq + 256]; mx = fmaxf(mx, s); }
#pragma unroll
            for (int o = 1; o < 64; o <<= 1) mx = fmaxf(mx, __shfl_xor(mx, o));
            float den = 0.f, num = 0.f;
            for (int kp = k0 + lane; kp < k1; kp += 64) { float s = 0.f; for (int d = 0; d < ADH; ++d) s += h2f(Z[(size_t)row * NQKV + h * ADH + d]) * h2f(Z[((size_t)b * SEQ + kp) * NQKV + D + h * ADH + d]);
                int dq = pos - kp; dq = dq > 256 ? 256 : (dq < -256 ? -256 : dq); s = s * 0.08838834764831845f + args.in[I_RELB][((size_t)eo * AH + h) * 513 + dq + 256];
                const float p = expf(s - mx); den += p; num += p * h2f(Z[((size_t)b * SEQ + kp) * NQKV + 2 * D + h * ADH + dd]); }
            den = wave_sum(den); num = wave_sum(num); const float want = num / den, got = h2f(Y[(size_t)row * D + h * ADH + dd]);
            if (lane == 0 && dbg_bad(got, want, 0.1f)) dbg_fail(ctl, step, got, want); }
    } else if (k == 2 && even) {
        const h16_t* DP = (const h16_t*)(ws + WS_DP);
        for (int i = gw; i < NS; i += NGW) { const unsigned hs = dbg_hash(i * 2654435761u + step); const int row = dbg_row(hs, i), col = (hs >> 5) % PW, gi = col >> 8;
            const float want = dbg_dot(DP, PW, row, gi * PGRP, PGRP, args.in[I_WPOOL] + ((size_t)eo * 4 + gi) * PGRP * PGRP, PGRP, col & 255, lane) * args.in[I_PSCALE][(size_t)eo * PW + col];
            const float got = h2f(Y[(size_t)row * D + col]);
            if (lane == 0 && dbg_bad(got, want, 0.2f)) dbg_fail(ctl, step, got, want); }
        const float* OI = (const float*)(ws + WS_OI);
        for (int i = gw; i < 512; i += NGW) { const unsigned hs = dbg_hash(i * 2654435761u + step + 7u); const int row = dbg_row(hs, i), h = (hs >> 9) & 3, vv = (hs >> 12) & 255; const int b = row / SEQ, pos = row % SEQ;
            float wdec[2] = {1.f, 1.f}, qv[2]; for (int x = 0; x < 2; ++x) qv[x] = h2f(Z[(size_t)row * P_PAD + OFF_Q + h * GDK + lane + 64 * x]) * 0.08838834764831845f;
            float acc = 0.f;
            for (int j = pos; j >= 0 && j > pos - 1024; --j) { const size_t rj = (size_t)b * SEQ + j;
                float part = 0.f; for (int x = 0; x < 2; ++x) part += qv[x] * h2f(Z[rj * P_PAD + OFF_K + h * GDK + lane + 64 * x]) * wdec[x];
                part = wave_sum(part); acc += part * h2f(Z[rj * P_PAD + OFF_V + h * GDV + vv]);
                for (int x = 0; x < 2; ++x) { const int d = lane + 64 * x; float gp = args.in[I_BGATE][(size_t)eo * 512 + h * GDK + d];
                    for (int r = 0; r < GRANK; ++r) gp += h2f(Z[rj * P_PAD + OFF_LR + r]) * args.in[I_WGLR][((size_t)eo * GRANK + r) * 512 + h * GDK + d];
                    wdec[x] *= expf(log_sigmoid(gp) * (1.f / 16.f)); } }
            const float got = OI[(size_t)row * (GH * GDV) + h * GDV + vv];
            if (lane == 0 && dbg_bad(got, acc, 0.3f)) dbg_fail(ctl, step, got, acc); }
    } else if (k == 3 && even) {
        const float* OI = (const float*)(ws + WS_OI);
        for (int i = gw; i < NS; i += NGW) { const unsigned hs = dbg_hash(i * 2654435761u + step); const int row = dbg_row(hs, i), h = (hs >> 9) & 3, vv = (hs >> 12) & 255;
            float s = 0.f; for (int x = lane; x < GDV; x += 64) s += OI[(size_t)row * 1024 + h * GDV + x]; const float mean = wave_sum(s) / GDV;
            float q = 0.f; for (int x = lane; x < GDV; x += 64) { const float d = OI[(size_t)row * 1024 + h * GDV + x] - mean; q += d * d; } const float var = wave_sum(q) / GDV;
            const float r = h2f(Z[(size_t)row * P_PAD + OFF_R + h * GDV + vv]);
            const float want = r / (1.f + expf(-r)) * ((OI[(size_t)row * 1024 + h * GDV + vv] - mean) / sqrtf(var + LN_EPS) * args.in[I_GNG][(size_t)eo * 1024 + h * GDV + vv]);
            const float got = h2f(Y[(size_t)row * D + PW + h * GDV + vv]);
            if (lane == 0 && dbg_bad(got, want, 0.1f)) dbg_fail(ctl, step, got, want); }
    } else if (k == 4 || k == 8) {
        for (int i = gw; i < NS; i += NGW) { const unsigned hs = dbg_hash(i * 2654435761u + step); const int row = dbg_row(hs, i), col = (hs >> 5) % D, b = row / SEQ;
            float dot;
            if (k == 4) dot = dbg_dot(Y, D, row, 0, D, even ? args.in[I_WOUT] + (size_t)eo * D * D : args.in[I_WO] + (size_t)eo * D * D, D, col, lane);
            else dot = dbg_dot(H, FF, row, 0, FF, args.in[I_WDOWN] + (size_t)l * FF * D, D, col, lane);
            const float xo = (k == 4 && l == 0) ? args.in[I_X][(size_t)row * D + col] : XD[(size_t)row * D + col];
            const float want = ALPHA * xo + (1.f + mod[((size_t)l * NB + b) * MODW + (k == 4 ? 2 : 5) * D + col]) * dot; const float got = args.out[(size_t)row * D + col];
            if (lane == 0 && dbg_bad(got, want, 0.1f)) dbg_fail(ctl, step, got, want); }
    } else if (k == 5 || k == 9) {
        const int which = k == 5 ? 0 : 1;
        for (int i = gw; i < NS; i += NGW) { const unsigned hs = dbg_hash(i * 2654435761u + step); const int row = dbg_row(hs, i), col = (hs >> 5) % D, b = row / SEQ;
            float s = 0.f; for (int x = lane; x < D; x += 64) s += XD[(size_t)row * D + x]; const float mean = wave_sum(s) / D;
            float q = 0.f; for (int x = lane; x < D; x += 64) { const float d = XD[(size_t)row * D + x] - mean; q += d * d; } const float var = wave_sum(q) / D;
            const float want = (XD[(size_t)row * D + col] - mean) / sqrtf(var + LN_EPS) * args.in[I_LNG][(size_t)(l * 2 + which) * D + col] + args.in[I_LNB][(size_t)(l * 2 + which) * D + col];
            const float got = args.out[(size_t)row * D + col];
            if (lane == 0 && dbg_bad(got, want, 0.02f)) dbg_fail(ctl, step, got, want);
            if (!(l == DEPTH - 1 && which == 1)) { const int lu = which == 0 ? l : l + 1; const float sc = mod[((size_t)lu * NB + b) * MODW + (which == 0 ? 4 * D : D) + col], sh = mod[((size_t)lu * NB + b) * MODW + (which == 0 ? 3 * D : 0) + col];
                const float wu = want * (1.f + sc) + sh, gu = h2f(U[(size_t)row * D + col]);
                if (lane == 0 && dbg_bad(gu, wu, 0.02f)) dbg_fail(ctl, step, gu, wu); } }
    } else if (k == 7) {
        const float* wup = args.in[I_WUP] + (size_t)l * D * NUP; const float* cw = args.in[I_CONVW] + (size_t)l * 3 * FF; const float* cb = args.in[I_CONVB] + (size_t)l * FF;
        for (int i = gw; i < NS; i += NGW) { const unsigned hs = dbg_hash(i * 2654435761u + step); const int row = dbg_row(hs, i), j = (hs >> 5) % FF, pos = row % SEQ;
            const float a = dbg_dot(U, D, row, 0, D, wup, NUP, j, lane), g0 = dbg_dot(U, D, row, 0, D, wup, NUP, FF + j, lane);
            const float g1 = pos >= 1 ? dbg_dot(U, D, row - 1, 0, D, wup, NUP, FF + j, lane) : 0.f, g2 = pos >= 2 ? dbg_dot(U, D, row - 2, 0, D, wup, NUP, FF + j, lane) : 0.f;
            const float gc = cb[j] + cw[j] * g2 + cw[FF + j] * g1 + cw[2 * FF + j] * g0;
            const float want = 0.5f * gc * (1.f + tanhf(0.7978845608028654f * (gc + 0.044715f * gc * gc * gc))) * a; const float got = h2f(H[(size_t)row * FF + j]);
            if (lane == 0 && dbg_bad(got, want, 0.1f)) dbg_fail(ctl, step, got, want); }
    }
}
__global__ void mk_report(Args args) {
    unsigned* ctl = (unsigned*)(args.ws + WS_CTL);
    const unsigned e = ctl[CW_ERR];
    if (e != 0u) args.out[0] = 1000.0f * (float)e;
    else if (ctl[CW_BAR + XB_TMO] != 0u) args.out[0] = 777000.0f;
}
#endif

extern "C" void kernel_launch(void* const* d_in, const int* in_sizes, int n_in, void* d_out, int out_size, void* d_ws, size_t ws_size, hipStream_t stream) {
    static int grid = 0;
    if (grid == 0) {
        if (n_in != 20 || in_sizes[0] != M * D || out_size != M * D || ws_size < WS_NEED) { fprintf(stderr, "kernel_launch: shape/workspace mismatch (n_in %d, in0 %d, out %d, ws %zu, need %zu); nothing launched\n", n_in, n_in > 0 ? in_sizes[0] : -1, out_size, ws_size, (size_t)WS_NEED); grid = -1; return; }
        int dev = 0, cus = 0, per_cu = 0;
        if (hipGetDevice(&dev) != hipSuccess || hipDeviceGetAttribute(&cus, hipDeviceAttributeMultiprocessorCount, dev) != hipSuccess) { grid = -1; return; }
        if (hipFuncSetAttribute((const void*)mk_fwd, hipFuncAttributeMaxDynamicSharedMemorySize, LDS_BYTES) != hipSuccess) { fprintf(stderr, "kernel_launch: hipFuncSetAttribute failed\n"); grid = -1; return; }
        if (hipOccupancyMaxActiveBlocksPerMultiprocessor(&per_cu, (const void*)mk_fwd, NTHR, LDS_BYTES) != hipSuccess || per_cu < 1) fprintf(stderr, "kernel_launch: occupancy query reports %d\n", per_cu);
        (void)hipGetLastError();
        grid = cus;
    }
    if (grid < 0) return;
    (void)hipMemsetAsync((char*)d_ws + WS_CTL, 0, CTL_ZERO_BYTES, stream);
    Args a{};
    for (int i = 0; i < 20; ++i) a.in[i] = (const float*)d_in[i];
    a.out = (float*)d_out; a.ws = (unsigned char*)d_ws;
#if MK_ONE
    a.s_lo = 0; a.s_hi = NSTEPS;
    hipLaunchKernelGGL(mk_fwd, dim3(grid), dim3(NTHR), LDS_BYTES, stream, a);
#else
    for (int s = 0; s < NSTEPS; ++s) {
        if (s >= 2) { const int l = (s - 2) / 10, k = (s - 2) % 10; if ((l & 1) && (k == 2 || k == 3)) continue; }
        a.s_lo = s; a.s_hi = s + 1;
#if MK_DEBUG
        if (s >= 2) { const int k = (s - 2) % 10, l = (s - 2) / 10; if ((k == 4 && l > 0) || k == 5 || k == 8 || k == 9) (void)hipMemcpyAsync((char*)d_ws + WS_DBG, d_out, (size_t)M * D * 4, hipMemcpyDeviceToDevice, stream); }
#endif
        hipLaunchKernelGGL(mk_fwd, dim3(grid), dim3(NTHR), LDS_BYTES, stream, a);
#if MK_DEBUG
        hipLaunchKernelGGL(mk_check, dim3(grid), dim3(NTHR), 0, stream, a, s);
#endif
    }
#if MK_DEBUG
    hipLaunchKernelGGL(mk_report, dim3(1), dim3(1), 0, stream, a);
#endif
#endif
}
```
